# Optimizing an MI355X kernel written in HIP

```python
import jax, jax.numpy as jnp
from jax import lax
import numpy as np

D_MODEL = 1024
BATCH = 8
SEQ = 8192
DEPTH = 1

HG_HEADS = 8
HG_DIM = 128
HG_WIDTH = HG_HEADS * HG_DIM
HG_CHUNK = 32
MLA_HEADS = 8
QK_NOPE = 128
QK_ROPE = 64
QK_DIM = QK_NOPE + QK_ROPE
V_DIM = 128
Q_LORA = 3 * D_MODEL // 8
KV_LORA = D_MODEL // 4
MLA_WIDTH = MLA_HEADS * V_DIM
Q_BLOCK = 128
ROPE_THETA = 10000.0
N_BRANCH = 2
EPS = 1e-6
IN_SPLITS = (HG_WIDTH, HG_WIDTH, HG_WIDTH, HG_WIDTH,
             Q_LORA, KV_LORA, QK_ROPE, MLA_WIDTH,
             N_BRANCH * D_MODEL)
IN_COLS = sum(IN_SPLITS)

kernel_name = "hgrn2_mla_gated_parallel_hybrid"


def _split_points():
    pts, acc = [], 0
    for w in IN_SPLITS[:-1]:
        acc += w
        pts.append(acc)
    return pts


def rms_norm(x, g):
    xf = x.astype(jnp.float32)
    y = xf * lax.rsqrt(jnp.mean(xf * xf, axis=-1, keepdims=True) + EPS)
    return (y * g.astype(jnp.float32)).astype(x.dtype)


def forget_lower_bounds(lb_logits):
    return jnp.cumsum(jax.nn.softmax(lb_logits.astype(jnp.float32), axis=0), axis=0)[:DEPTH]


def rope_tables(seq):
    inv = ROPE_THETA ** (-jnp.arange(0, QK_ROPE, 2, dtype=jnp.float32) / QK_ROPE)
    ang = jnp.arange(seq, dtype=jnp.float32)[:, None] * inv[None, :]
    return jnp.cos(ang), jnp.sin(ang)


def apply_rope(x, cos, sin):
    xf = x.astype(jnp.float32)
    x1, x2 = xf[..., : QK_ROPE // 2], xf[..., QK_ROPE // 2:]
    out = jnp.concatenate([x1 * cos - x2 * sin, x2 * cos + x1 * sin], axis=-1)
    return out.astype(x.dtype)


def hgrn2_recurrence(q, k, v, log_f):
    B, S, H, dk = q.shape
    dv = v.shape[-1]
    C = HG_CHUNK
    N = S // C

    def to_chunks(t):
        return t.reshape(B, N, C, H, t.shape[-1]).transpose(1, 0, 3, 2, 4)

    q, k, v, log_f = to_chunks(q), to_chunks(k), to_chunks(v), to_chunks(log_f)
    b = jnp.cumsum(log_f, axis=3)
    b_last = b[:, :, :, -1:, :]
    q_in = q * jnp.exp(b)
    k_in = k * jnp.exp(-b)
    k_out = k * jnp.exp(b_last - b)
    chunk_decay = jnp.exp(b_last[:, :, :, 0, :])

    causal = jnp.tril(jnp.ones((C, C), dtype=bool))
    scores = jnp.einsum('nbhtk,nbhsk->nbhts', q_in, k_in)
    scores = jnp.where(causal, scores, 0.0)
    o_intra = jnp.einsum('nbhts,nbhsv->nbhtv', scores, v)

    def step(state, inp):
        q_n, k_n, v_n, dec_n = inp
        o_inter = jnp.einsum('bhtk,bhkv->bhtv', q_n, state)
        state = state * dec_n[..., None] + jnp.einsum('bhsk,bhsv->bhkv', k_n, v_n)
        return state, o_inter

    state0 = jnp.zeros((B, H, dk, dv), jnp.float32)
    _, o_inter = lax.scan(step, state0, (q_in, k_out, v, chunk_decay))
    o = o_intra + o_inter
    return o.transpose(1, 0, 3, 2, 4).reshape(B, S, H, dv)


def hgrn2_branch(hq, hf, hi, hz, lb, hg_norm_g):
    B, S, _ = hq.shape
    dt = hq.dtype
    f = lb + (1.0 - lb) * jax.nn.sigmoid(hf.astype(jnp.float32))
    q = jax.nn.silu(hq.astype(jnp.float32)).reshape(B, S, HG_HEADS, HG_DIM)
    k = (1.0 - f).reshape(B, S, HG_HEADS, HG_DIM)
    v = hi.astype(jnp.float32).reshape(B, S, HG_HEADS, HG_DIM)
    log_f = jnp.log(f).reshape(B, S, HG_HEADS, HG_DIM)
    o = hgrn2_recurrence(q, k, v, log_f).astype(dt)
    o = rms_norm(o, hg_norm_g)
    o = o * jax.nn.silu(hz).reshape(B, S, HG_HEADS, HG_DIM)
    return o.reshape(B, S, HG_WIDTH)


def mla_branch(cq, ckv, kr, mz, q_a_g, w_uq, kv_a_g, w_ukv):
    B, S, _ = cq.shape
    cos, sin = rope_tables(S)
    q = (rms_norm(cq, q_a_g) @ w_uq).reshape(B, S, MLA_HEADS, QK_DIM)
    q_nope = q[..., :QK_NOPE]
    q_pe = apply_rope(q[..., QK_NOPE:], cos[:, None, :], sin[:, None, :])
    kv = (rms_norm(ckv, kv_a_g) @ w_ukv).reshape(B, S, MLA_HEADS, QK_NOPE + V_DIM)
    k_nope, v = kv[..., :QK_NOPE], kv[..., QK_NOPE:]
    k_pe = apply_rope(kr, cos, sin)
    scale = QK_DIM ** -0.5
    key_pos = jnp.arange(S)

    def attend_block(blk):
        start = blk * Q_BLOCK
        qn = lax.dynamic_slice_in_dim(q_nope, start, Q_BLOCK, axis=1)
        qp = lax.dynamic_slice_in_dim(q_pe, start, Q_BLOCK, axis=1)
        s = (jnp.einsum('bqhd,bkhd->bhqk', qn, k_nope)
             + jnp.einsum('bqhr,bkr->bhqk', qp, k_pe)).astype(jnp.float32) * scale
        q_pos = start + jnp.arange(Q_BLOCK)
        s = jnp.where(q_pos[:, None] >= key_pos[None, :], s, -jnp.inf)
        p = jax.nn.softmax(s, axis=-1).astype(v.dtype)
        return jnp.einsum('bhqk,bkhd->bqhd', p, v)

    out = lax.map(attend_block, jnp.arange(S // Q_BLOCK))
    out = out.transpose(1, 0, 2, 3, 4).reshape(B, S, MLA_WIDTH)
    return out * jax.nn.silu(mz)


def setup_inputs(seed: int = 0) -> dict:
    key = jax.random.key(seed)
    ks = jax.random.split(key, 16)
    f32 = jnp.float32

    def w(k, shape, fan_in):
        return jax.random.normal(k, shape, f32) * fan_in ** -0.5

    def gain(k, shape):
        return 1.0 + 0.02 * jax.random.normal(k, shape, f32)

    return {
        "x": jax.random.normal(ks[0], (BATCH, SEQ, D_MODEL), f32),
        "norm_g": gain(ks[1], (DEPTH, D_MODEL)),
        "w_in": w(ks[2], (DEPTH, D_MODEL, IN_COLS), D_MODEL),
        "b_gate": 0.02 * jax.random.normal(ks[3], (DEPTH, N_BRANCH * D_MODEL), f32),
        "lb_logits": 0.1 * jax.random.normal(ks[4], (DEPTH + 1, HG_WIDTH), f32),
        "hg_norm_g": gain(ks[5], (DEPTH, HG_DIM)),
        "q_a_g": gain(ks[6], (DEPTH, Q_LORA)),
        "w_uq": w(ks[7], (DEPTH, Q_LORA, MLA_HEADS * QK_DIM), Q_LORA),
        "kv_a_g": gain(ks[8], (DEPTH, KV_LORA)),
        "w_ukv": w(ks[9], (DEPTH, KV_LORA, MLA_HEADS * (QK_NOPE + V_DIM)), KV_LORA),
        "w_proj_a": w(ks[10], (DEPTH, HG_WIDTH, D_MODEL), HG_WIDTH),
        "w_proj_b": w(ks[11], (DEPTH, MLA_WIDTH, D_MODEL), MLA_WIDTH),
        "w_out": w(ks[12], (DEPTH, D_MODEL, D_MODEL), D_MODEL),
        "final_norm_g": gain(ks[13], (D_MODEL,)),
    }


def reference(x, norm_g, w_in, b_gate, lb_logits, hg_norm_g, q_a_g, w_uq, kv_a_g, w_ukv,
              w_proj_a, w_proj_b, w_out, final_norm_g):
    B, S, _ = x.shape
    lower_bounds = forget_lower_bounds(lb_logits)
    pts = _split_points()
    for l in range(DEPTH):
        h = rms_norm(x, norm_g[l])
        proj = h @ w_in[l]
        hq, hf, hi, hz, cq, ckv, kr, mz, glog = jnp.split(proj, pts, axis=-1)
        y_a = hgrn2_branch(hq, hf, hi, hz, lower_bounds[l], hg_norm_g[l])
        y_b = mla_branch(cq, ckv, kr, mz, q_a_g[l], w_uq[l], kv_a_g[l], w_ukv[l])
        gates = jax.nn.sigmoid((glog + b_gate[l]).astype(jnp.float32)).astype(x.dtype)
        gates = gates.reshape(B, S, N_BRANCH, D_MODEL)
        merged = gates[:, :, 0] * (y_a @ w_proj_a[l]) + gates[:, :, 1] * (y_b @ w_proj_b[l])
        x = x + merged @ w_out[l]
    return rms_norm(x, final_norm_g)
```

```cpp
#include <hip/hip_runtime.h>
#include <hip/hip_cooperative_groups.h>
#include <cstdio>
#include <cstdint>
#include <cmath>
namespace cg = cooperative_groups;
#ifndef REP1
#define REP1 1
#endif
#ifndef REP3
#define REP3 1
#endif
#ifndef REPS
#define REPS 1
#endif
#ifndef REPG
#define REPG 1
#endif
#ifndef REP0
#define REP0 1
#endif
#ifndef REP7
#define REP7 1
#endif
#ifndef REPQ
#define REPQ 1
#endif

#define LAS __attribute__((address_space(3)))
typedef unsigned short bf16_t;
typedef short bf16x8 __attribute__((ext_vector_type(8)));
typedef float f32x4 __attribute__((ext_vector_type(4)));
typedef unsigned u32x4 __attribute__((ext_vector_type(4)));
typedef unsigned u32x2 __attribute__((ext_vector_type(2)));

constexpr int DM = 1024, BATCH = 8, SEQ = 8192, TTOK = BATCH * SEQ;
constexpr int TH = TTOK, BPP = BATCH;
constexpr int NIN = 7872, NINP = 7936;
constexpr int NHC = 4096, NRC = 3840;
constexpr int R_CQ = 0, R_CKV = 384, R_KR = 640, R_MZ = 704, R_GL = 1728;
constexpr int C_HQ = 0, C_HF = 1024, C_HI = 2048, C_HZ = 3072, C_CQ = 4096, C_CKV = 4480, C_KR = 4736, C_MZ = 4800, C_GL = 5824;
constexpr int QLORA = 384, KVLORA = 256, NQ = 1536, NKV = 2048;
constexpr float EPS = 1e-6f;
constexpr float ATT_SCALE = 0.07216878364870322f;

constexpr size_t al256(size_t x) { return (x + 255) & ~(size_t)255; }
constexpr size_t WS_WIN = 0;
constexpr size_t WS_WUQ = WS_WIN + (size_t)NINP * DM * 2;
constexpr size_t WS_WUKV = WS_WUQ + (size_t)NQ * QLORA * 2;
constexpr size_t WS_WP = WS_WUKV + (size_t)NKV * KVLORA * 2;
constexpr size_t WS_WOUT = WS_WP + (size_t)2048 * 1024 * 2;
constexpr size_t WS_COS = WS_WOUT + (size_t)1024 * 1024 * 2;
constexpr size_t WS_SIN = WS_COS + (size_t)SEQ * 32 * 4;
constexpr size_t WS_LB = WS_SIN + (size_t)SEQ * 32 * 4;
constexpr size_t WS_CTR = WS_LB + 4096;
constexpr size_t WS_BAR = al256(WS_CTR + 256);
constexpr size_t WS_PH = al256(WS_BAR + 16384);
constexpr size_t WS_PR = WS_PH + (size_t)TTOK * NHC * 2;
constexpr size_t WS_END = WS_PR + (size_t)TTOK * NRC * 2;
constexpr size_t WS_Q = WS_PH;
constexpr size_t WS_KV = WS_Q + (size_t)TTOK * NQ * 2;
constexpr size_t WS_KPE = WS_KV + (size_t)TTOK * NKV * 2;
constexpr size_t WS_T1 = WS_PH;
constexpr size_t WS_MG = WS_T1 + (size_t)TTOK * 1024 * 2;
static_assert(WS_END <= (size_t)1073741824, "workspace map must fit 1 GiB");
static_assert(WS_KPE + (size_t)TTOK * 64 * 2 <= WS_PR && WS_MG + (size_t)TTOK * 1024 * 2 <= WS_PR, "overlays fit inside PH");
constexpr size_t OUT_H_OFF = (size_t)TTOK * DM * 2;
constexpr int YB_OFF_EL = TTOK * DM;

constexpr int LDS_BYTES = 147456;

__device__ __forceinline__ unsigned f2bf(float f) { unsigned u = __builtin_bit_cast(unsigned, f); return (u + 0x7fffu + ((u >> 16) & 1u)) >> 16; }
__device__ __forceinline__ unsigned pk2(float lo, float hi) { return f2bf(lo) | (f2bf(hi) << 16); }
typedef float f32x2_t __attribute__((ext_vector_type(2))); typedef __bf16 bf16x2_t __attribute__((ext_vector_type(2)));
__device__ __forceinline__ unsigned cvtpk_s(float lo, float hi) { f32x2_t v = {lo, hi}; bf16x2_t b = __builtin_convertvector(v, bf16x2_t); return __builtin_bit_cast(unsigned, b); }
__device__ __forceinline__ float bf2f(unsigned short b) { return __builtin_bit_cast(float, (unsigned)b << 16); }
__device__ __forceinline__ float bflo(unsigned w) { return __builtin_bit_cast(float, w << 16); }
__device__ __forceinline__ float bfhi(unsigned w) { return __builtin_bit_cast(float, w & 0xffff0000u); }
__device__ __forceinline__ float sigmoidf_(float x) { return __builtin_amdgcn_rcpf(1.f + __expf(-x)); }
__device__ __forceinline__ float siluf_(float x) { return x * __builtin_amdgcn_rcpf(1.f + __expf(-x)); }
__device__ __forceinline__ float wave_sum(float v) {
#pragma unroll
    for (int o = 1; o < 64; o <<= 1) v += __shfl_xor(v, o);
    return v;
}
__device__ __forceinline__ float wave_max(float v) {
#pragma unroll
    for (int o = 1; o < 64; o <<= 1) v = fmaxf(v, __shfl_xor(v, o));
    return v;
}
#define LDS_WAIT() asm volatile("s_waitcnt lgkmcnt(0)" ::: "memory")
#define LAUNDER(v) asm volatile("" : "+v"(v))
__device__ __forceinline__ int lane_id_v() { int l; asm volatile("v_mbcnt_lo_u32_b32 %0, -1, 0\n\tv_mbcnt_hi_u32_b32 %0, -1, %0" : "=v"(l)); return l; }
__device__ __forceinline__ int wave_id_s() { int w = (int)threadIdx.x >> 6; return __builtin_amdgcn_readfirstlane(w); }

namespace pg8 {
constexpr int BM = 256, BK = 64, HALF = 128, HTB = HALF * BK * 2, STAGE_BYTES = 8 * HTB, NXCD = 8, WGM = 8;
__host__ __device__ __forceinline__ int lds_byte(int r, int c) { const int st = (r >> 4) * 2 + (c >> 5), rr = r & 15, cc = c & 31, ob = rr * 64 + cc * 2; return st * 1024 + (ob ^ (((ob >> 9) & 1) << 5)); }
__host__ __device__ __forceinline__ void stage_rc(int b, int& R, int& C) { const int st = b / 1024, sb = b % 1024, swz = sb ^ (((sb >> 9) & 1) << 5); R = (st >> 1) * 16 + swz / 64; C = (st & 1) * 32 + (swz % 64) / 2; }
__host__ __device__ __forceinline__ int perm32(int rho) { const int n = rho >> 4, i = rho & 15; return 8 * (i >> 2) + 4 * n + (i & 3); }

struct Unit { int pm, pn, acol; };
struct Gemm { const bf16_t* A; const bf16_t* Bt; int lda, ldb, K; };

struct TileOrder {
    int nM, nN, nwg, G, c;
    __device__ void init(int M, int N, int G_, int c_) { nM = M / BM; nN = N / BM; nwg = nM * nN; G = G_; c = c_; }
    __device__ bool tile(int i, int& pm, int& pn) const {
        const long L = (long)i * G + c; if (L >= nwg) return false;
        int wgid = (int)L; { const int q = nwg / NXCD, r = nwg % NXCD, xcd = wgid % NXCD, off = wgid / NXCD; wgid = (xcd < r ? xcd * (q + 1) : r * (q + 1) + (xcd - r) * q) + off; }
        const int nig = WGM * nN, gid = wgid / nig, fm = gid * WGM, gsz = (nM - fm) < WGM ? (nM - fm) : WGM;
        pm = fm + ((wgid % nig) % gsz); pn = (wgid % nig) / gsz; return true;
    }
};
struct SchedPlain { TileOrder o; int per, rep; __device__ bool next(int i, Unit& u) const { int pm, pn; if (rep > 1) { if (i >= per * rep) return false; i = i % per; } if (!o.tile(i, pm, pn)) return false; u.pm = pm; u.pn = pn; u.acol = 0; return true; } };
struct SchedRow { int pm; __device__ bool next(int i, Unit& u) const { if (i >= 4) return false; u.pm = pm; u.pn = i; u.acol = 0; return true; } };
struct SchedAB { TileOrder o; int per, rep; __device__ bool next(int i, Unit& u) const { int pm, pn; if (rep > 1) { if (i >= per * rep) return false; i = i % per; } if (!o.tile(i >> 1, pm, pn)) return false; const int w = i & 1; u.pm = pm; u.pn = pn + 4 * w; u.acol = YB_OFF_EL * w; return true; } };

__device__ __forceinline__ unsigned cvt_pk_bf16(float lo, float hi) { unsigned r; asm volatile("v_cvt_pk_bf16_f32 %0, %1, %2" : "=v"(r) : "v"(lo), "v"(hi)); return r; }

struct EpiBf16 {
    static constexpr bool PERM = true;
    bf16_t* O; int ldc;
    __device__ __forceinline__ void operator()(const f32x4 (&acc)[2][2][4][2], const Unit& u, int wr, int wc, int fr, int fq) const {
        const int row0 = u.pm * BM + wr * 64 + fr; const int col0 = u.pn * BM + wc * 32 + 8 * fq;
#pragma unroll
        for (int ai = 0; ai < 2; ++ai)
#pragma unroll
            for (int m = 0; m < 4; ++m) { bf16_t* rowp = O + (size_t)(row0 + ai * HALF + m * 16) * ldc + col0;
#pragma unroll
                for (int bj = 0; bj < 2; ++bj) { const f32x4 v0 = acc[ai][bj][m][0], v1 = acc[ai][bj][m][1];
                    u32x4 w; w.x = cvt_pk_bf16(v0[0], v0[1]); w.y = cvt_pk_bf16(v0[2], v0[3]); w.z = cvt_pk_bf16(v1[0], v1[1]); w.w = cvt_pk_bf16(v1[2], v1[3]);
                    *(u32x4*)(rowp + bj * HALF) = w; } }
    }
};

struct EpiQRope {
    static constexpr bool PERM = true;
    bf16_t* O; const float* cosT; const float* sinT;
    __device__ __forceinline__ void operator()(const f32x4 (&acc)[2][2][4][2], const Unit& u, int wr, int wc, int fr, int fq) const {
        const int row0 = u.pm * BM + wr * 64 + fr; const int col0 = u.pn * BM + wc * 32 + 8 * fq; const bool rope = u.pn >= 4;
#pragma unroll
        for (int ai = 0; ai < 2; ++ai)
#pragma unroll
            for (int m = 0; m < 4; ++m) { const int row = row0 + ai * HALF + m * 16; bf16_t* rowp = O + (size_t)row * NQ + col0;
                f32x4 a0 = acc[ai][0][m][0], a1 = acc[ai][0][m][1], b0 = acc[ai][1][m][0], b1 = acc[ai][1][m][1];
                if (rope) { const int pos = row & (SEQ - 1); const f32x4 c0 = *(const f32x4*)(cosT + pos * 32 + 8 * fq), c1 = *(const f32x4*)(cosT + pos * 32 + 8 * fq + 4);
                    const f32x4 s0 = *(const f32x4*)(sinT + pos * 32 + 8 * fq), s1 = *(const f32x4*)(sinT + pos * 32 + 8 * fq + 4);
                    const f32x4 x0 = a0 * c0 - b0 * s0, x1 = a1 * c1 - b1 * s1, y0 = b0 * c0 + a0 * s0, y1 = b1 * c1 + a1 * s1; a0 = x0; a1 = x1; b0 = y0; b1 = y1; }
                u32x4 w; w.x = cvt_pk_bf16(a0[0], a0[1]); w.y = cvt_pk_bf16(a0[2], a0[3]); w.z = cvt_pk_bf16(a1[0], a1[1]); w.w = cvt_pk_bf16(a1[2], a1[3]); *(u32x4*)rowp = w;
                w.x = cvt_pk_bf16(b0[0], b0[1]); w.y = cvt_pk_bf16(b0[2], b0[3]); w.z = cvt_pk_bf16(b1[0], b1[1]); w.w = cvt_pk_bf16(b1[2], b1[3]); *(u32x4*)(rowp + HALF) = w; }
    }
};
struct EpiGate {
    static constexpr bool PERM = true;
    const bf16_t* P; const float* bgate; bf16_t* T1; bf16_t* MG;
    __device__ __forceinline__ void operator()(const f32x4 (&acc)[2][2][4][2], const Unit& u, int wr, int wc, int fr, int fq) const {
        const int which = u.pn >> 2; const int row0 = u.pm * BM + wr * 64 + fr; const int col0 = (u.pn & 3) * BM + wc * 32 + 8 * fq;
#pragma unroll
        for (int bj = 0; bj < 2; ++bj) { const int col = col0 + bj * HALF;
            const f32x4 b0 = *(const f32x4*)(bgate + which * 1024 + col), b1 = *(const f32x4*)(bgate + which * 1024 + col + 4);
#pragma unroll
            for (int ai = 0; ai < 2; ++ai)
#pragma unroll
                for (int m = 0; m < 4; ++m) { const size_t row = (size_t)(row0 + ai * HALF + m * 16);
                    const u32x4 gl = *(const u32x4*)(P + row * NRC + R_GL + which * 1024 + col);
                    const f32x4 v0 = acc[ai][bj][m][0], v1 = acc[ai][bj][m][1];
                    float r[8];
                    r[0] = sigmoidf_(bflo(gl.x) + b0[0]) * v0[0]; r[1] = sigmoidf_(bfhi(gl.x) + b0[1]) * v0[1];
                    r[2] = sigmoidf_(bflo(gl.y) + b0[2]) * v0[2]; r[3] = sigmoidf_(bfhi(gl.y) + b0[3]) * v0[3];
                    r[4] = sigmoidf_(bflo(gl.z) + b1[0]) * v1[0]; r[5] = sigmoidf_(bfhi(gl.z) + b1[1]) * v1[1];
                    r[6] = sigmoidf_(bflo(gl.w) + b1[2]) * v1[2]; r[7] = sigmoidf_(bfhi(gl.w) + b1[3]) * v1[3];
                    if (which == 0) { u32x4 w; w.x = cvt_pk_bf16(r[0], r[1]); w.y = cvt_pk_bf16(r[2], r[3]); w.z = cvt_pk_bf16(r[4], r[5]); w.w = cvt_pk_bf16(r[6], r[7]);
                        *(u32x4*)(T1 + row * 1024 + col) = w; }
                    else { const u32x4 t = *(const u32x4*)(T1 + row * 1024 + col);
                        u32x4 w; w.x = cvt_pk_bf16(r[0] + bflo(t.x), r[1] + bfhi(t.x)); w.y = cvt_pk_bf16(r[2] + bflo(t.y), r[3] + bfhi(t.y));
                        w.z = cvt_pk_bf16(r[4] + bflo(t.z), r[5] + bfhi(t.z)); w.w = cvt_pk_bf16(r[6] + bflo(t.w), r[7] + bfhi(t.w));
                        *(u32x4*)(MG + row * 1024 + col) = w; } } }
    }
};
struct EpiResid {
    static constexpr bool PERM = false;
    const float* X; float* O;
    __device__ __forceinline__ void operator()(const f32x4 (&acc)[2][2][4][2], const Unit& u, int wr, int wc, int fr, int fq) const {
        const int row0 = u.pm * BM + wr * 64 + fr; const int col0 = u.pn * BM + wc * 32 + 4 * fq;
#pragma unroll
        for (int ai = 0; ai < 2; ++ai)
#pragma unroll
            for (int m = 0; m < 4; ++m) { const size_t off = (size_t)(row0 + ai * HALF + m * 16) * 1024 + col0;
#pragma unroll
                for (int bj = 0; bj < 2; ++bj)
#pragma unroll
                    for (int n = 0; n < 2; ++n) { const f32x4 xv = *(const f32x4*)(X + off + bj * HALF + n * 16); *(f32x4*)(O + off + bj * HALF + n * 16) = xv + acc[ai][bj][m][n]; } }
    }
};

template <class Epi, class Sched>
__device__ __forceinline__ void gemm_phase(LAS unsigned char* lds, const Gemm g, const Sched& S, const Epi& E, const int wave_s) {
    const int wid = wave_s;
    const int tid = wid * 64 + lane_id_v(), lane = tid & 63, wr = wid >> 2, wc = wid & 3, fr = lane & 15, fq = lane >> 4;
    const int K = g.K, nt = K / BK;
    unsigned voffA[2], voffB[2];
#pragma unroll
    for (int i = 0; i < 2; ++i) { int R, C; stage_rc(tid * 16 + i * 8192, R, C); const int Rb = Epi::PERM ? ((R & ~31) + perm32(R & 31)) : R;
        voffA[i] = (unsigned)(R * g.lda + C) * 2u; voffB[i] = (unsigned)(Rb * g.ldb + C) * 2u; }
    const size_t kstep = (size_t)(BK * 2);
    const size_t hstepA = (size_t)HALF * g.lda * 2, hstepB = (size_t)HALF * g.ldb * 2;
    const size_t tstepA = 2 * hstepA, tstepB = 2 * hstepB;
    const unsigned ldsw = (unsigned)wid * 1024u;
    const int aoff = lds_byte(wr * 64 + fr, fq * 8), boff = lds_byte(wc * 32 + fr, fq * 8);
#define PG8_SA(b, h) (((b) * 2 + (h)) * HTB)
#define PG8_SB(b, h) ((4 + (b) * 2 + (h)) * HTB)
#define PG8_STAGE(bufoff, gbase, voff) do { _Pragma("unroll") for (int _i = 0; _i < 2; ++_i) \
        __builtin_amdgcn_global_load_lds((const unsigned*)((const char*)(gbase) + (voff)[_i]), (LAS unsigned*)(lds + (bufoff) + ldsw + _i * 8192), 16, 0, 0); } while (0)
#define PG8_LDA(dst, b, h) do { _Pragma("unroll") for (int m = 0; m < 4; ++m) _Pragma("unroll") for (int k = 0; k < 2; ++k) dst[m][k] = *(const LAS bf16x8*)(lds + PG8_SA(b, h) + aoff + m * 2048 + k * 1024); } while (0)
#define PG8_LDB(dst, b, h) do { _Pragma("unroll") for (int n = 0; n < 2; ++n) _Pragma("unroll") for (int k = 0; k < 2; ++k) dst[n][k] = *(const LAS bf16x8*)(lds + PG8_SB(b, h) + boff + n * 2048 + k * 1024); } while (0)
#define PG8_MMA(ai, bj, At, Bt) do { __builtin_amdgcn_s_setprio(1); _Pragma("unroll") for (int m = 0; m < 4; ++m) _Pragma("unroll") for (int n = 0; n < 2; ++n) _Pragma("unroll") for (int k = 0; k < 2; ++k) \
        acc[ai][bj][m][n] = __builtin_amdgcn_mfma_f32_16x16x32_bf16(Bt[n][k], At[m][k], acc[ai][bj][m][n], 0, 0, 0); __builtin_amdgcn_s_setprio(0); } while (0)
#define PG8_WAIT_V(n) asm volatile("s_waitcnt vmcnt(" #n ")" ::: "memory")
#define PG8_WAIT_L(n) asm volatile("s_waitcnt lgkmcnt(" #n ")" ::: "memory")
#define PG8_BAR __builtin_amdgcn_s_barrier()
#define PG8_SCHED __builtin_amdgcn_sched_barrier(0)
    Unit cur, nxt; int ui = 0;
    if (!S.next(0, cur)) return;
    f32x4 acc[2][2][4][2];
#pragma unroll
    for (int a = 0; a < 2; ++a)
#pragma unroll
        for (int b = 0; b < 2; ++b)
#pragma unroll
            for (int m = 0; m < 4; ++m)
#pragma unroll
                for (int n = 0; n < 2; ++n) acc[a][b][m][n] = (f32x4){0.f, 0.f, 0.f, 0.f};
    bf16x8 At[4][2], B0[2][2], B1[2][2];
    const char* cA = (const char*)g.A + (size_t)cur.pm * tstepA + (size_t)cur.acol * 2; const char* cB = (const char*)g.Bt + (size_t)cur.pn * tstepB;
    PG8_STAGE(PG8_SB(0, 0), cB, voffB); PG8_STAGE(PG8_SB(0, 1), cB + hstepB, voffB); PG8_STAGE(PG8_SA(0, 0), cA, voffA); PG8_STAGE(PG8_SA(0, 1), cA + hstepA, voffA);
    if (wr == 1) PG8_BAR;
    PG8_WAIT_V(2); PG8_BAR;
    PG8_STAGE(PG8_SB(1, 0), cB + kstep, voffB); PG8_STAGE(PG8_SA(1, 0), cA + kstep, voffA); PG8_STAGE(PG8_SB(1, 1), cB + hstepB + kstep, voffB);
    PG8_WAIT_V(6); PG8_BAR;
    for (;;) {
        const bool has_next = S.next(ui + 1, nxt);
        const char* nA = has_next ? (const char*)g.A + (size_t)nxt.pm * tstepA + (size_t)nxt.acol * 2 : cA; const char* nB = has_next ? (const char*)g.Bt + (size_t)nxt.pn * tstepB : cB;
#pragma unroll 1
        for (int t = 0; t < nt; t += 2) {
            const bool last = (t == nt - 2);
            const char* a1 = cA + (size_t)(t + 1) * kstep;
            const char* a2 = last ? nA : cA + (size_t)(t + 2) * kstep; const char* b2 = last ? nB : cB + (size_t)(t + 2) * kstep;
            const char* a3 = a2 + kstep; const char* b3 = b2 + kstep;
            PG8_LDB(B0, 0, 0); PG8_LDB(B1, 0, 1); PG8_SCHED; PG8_LDA(At, 0, 0); PG8_STAGE(PG8_SA(1, 1), a1 + hstepA, voffA);
            PG8_WAIT_V(8); PG8_WAIT_L(0); PG8_BAR; PG8_MMA(0, 0, At, B0); PG8_MMA(0, 1, At, B1); PG8_BAR; PG8_SCHED;
            PG8_LDA(At, 0, 1); PG8_STAGE(PG8_SB(0, 0), b2, voffB); PG8_STAGE(PG8_SB(0, 1), b2 + hstepB, voffB); PG8_STAGE(PG8_SA(0, 0), a2, voffA);
            PG8_WAIT_V(8); PG8_WAIT_L(0); PG8_BAR; PG8_MMA(1, 0, At, B0); PG8_MMA(1, 1, At, B1); PG8_BAR; PG8_SCHED;
            PG8_LDB(B0, 1, 0); PG8_LDB(B1, 1, 1); PG8_SCHED; PG8_LDA(At, 1, 0); PG8_STAGE(PG8_SA(0, 1), a2 + hstepA, voffA);
            PG8_WAIT_V(8); PG8_WAIT_L(0); PG8_BAR; PG8_MMA(0, 0, At, B0); PG8_MMA(0, 1, At, B1); PG8_BAR; PG8_SCHED;
            PG8_LDA(At, 1, 1); PG8_STAGE(PG8_SB(1, 0), b3, voffB); PG8_STAGE(PG8_SB(1, 1), b3 + hstepB, voffB); PG8_STAGE(PG8_SA(1, 0), a3, voffA);
            PG8_WAIT_V(8); PG8_WAIT_L(0); PG8_BAR; PG8_MMA(1, 0, At, B0); PG8_MMA(1, 1, At, B1); PG8_BAR; PG8_SCHED;
        }
        if (wr == 0) PG8_BAR;
        E(acc, cur, wr, wc, fr, fq);
        if (!has_next) break;
#pragma unroll
        for (int a = 0; a < 2; ++a)
#pragma unroll
            for (int b = 0; b < 2; ++b)
#pragma unroll
                for (int m = 0; m < 4; ++m)
#pragma unroll
                    for (int n = 0; n < 2; ++n) acc[a][b][m][n] = (f32x4){0.f, 0.f, 0.f, 0.f};
        cur = nxt; cA = nA; cB = nB; ++ui;
        if (wr == 1) PG8_BAR;
    }
    PG8_WAIT_V(0);
    PG8_BAR;
#undef PG8_SA
#undef PG8_SB
#undef PG8_STAGE
#undef PG8_LDA
#undef PG8_LDB
#undef PG8_MMA
#undef PG8_WAIT_V
#undef PG8_WAIT_L
#undef PG8_BAR
#undef PG8_SCHED
}
}

__device__ __forceinline__ int qmap(int n) { const int h = n / 192, d = n % 192; if (d < 128) return h * 128 + d; const int i = d - 128; return 1024 + (h >> 2) * 256 + (i >> 5) * 128 + (h & 3) * 32 + (i & 31); }
template <bool QMAP = false>
__device__ __forceinline__ void transpose_item(const float* W, int K, int N, bf16_t* WT, int row_off, const float* gain, LAS float* scr, int item, int lane) {
    const int nblk = N / 32, kb = item / nblk, nb = item % nblk, k0 = 64 * kb, n0 = 32 * nb; const int d0 = QMAP ? qmap(n0) : n0;
#pragma unroll 8
    for (int i = 0; i < 32; ++i) { const int kk = 2 * i + (lane >> 5); const float gk = gain ? gain[k0 + kk] : 1.f; scr[kk * 33 + (lane & 31)] = W[(size_t)(k0 + kk) * N + n0 + (lane & 31)] * gk; }
    LDS_WAIT(); asm volatile("" ::: "memory");
    const int c = lane & 7;
#pragma unroll
    for (int j = 0; j < 4; ++j) { const int n = (lane >> 3) + 8 * j; const LAS float* s = scr + (8 * c) * 33 + n;
        u32x4 o; o.x = pk2(s[0 * 33], s[1 * 33]); o.y = pk2(s[2 * 33], s[3 * 33]); o.z = pk2(s[4 * 33], s[5 * 33]); o.w = pk2(s[6 * 33], s[7 * 33]);
        *(u32x4*)(WT + (size_t)(row_off + d0 + n) * K + k0 + 8 * c) = o; }
    LDS_WAIT(); asm volatile("" ::: "memory");
}

struct Args { const float* in[14]; float* out; unsigned char* ws; float inv[32]; };

namespace att {
typedef short s16x4 __attribute__((ext_vector_type(4)));
typedef float f32x16 __attribute__((ext_vector_type(16)));
constexpr int NW = 8, QBLK = 32, KVBLK = 64, QB = 256;
constexpr int SHM_V = 16384, SHM_K = 17408, SHM_R = 9216;
constexpr int OFF_V = 0, OFF_K = 3 * SHM_V,     OFF_R = OFF_K + 2 * SHM_K, OFF_WS = OFF_R + 2 * SHM_R, OFF_QR = OFF_WS + NW * 64 * 4, ATT_LDS = OFF_QR + NW * 4096;
constexpr float THR = 8.f;
#define KSWZ(row, colB) ((row) * 272 + (colB))
#define RSWZ(row, colB) ((row) * 144 + (colB))
#define SBAR() __builtin_amdgcn_sched_barrier(0)
__device__ __forceinline__ int v_st(int k, int c) { const int kk = (k & ~0xC) | ((k & 4) << 1) | ((k & 8) >> 1); return ((kk >> 3) * 4 + (c >> 5)) * 512 + ((kk & 7) * 32 + (c & 31)) * 2; }
__device__ __forceinline__ int v_rd_base(int lane) { return ((lane & 3) << 3) | (((lane >> 2) & 3) << 6) | (((lane >> 4) & 1) << 5) | (((lane >> 5) & 1) << 8); }
constexpr int v_rd_off(int d0, int ks, int half) { return d0 * 512 + ks * 4096 + half * 2048; }
__device__ __forceinline__ int crow(int r, int hi) { return (r & 3) + 8 * (r >> 2) + 4 * hi; }
__device__ __forceinline__ unsigned cvtpk(float lo, float hi) { unsigned r; asm volatile("v_cvt_pk_bf16_f32 %0, %1, %2" : "=v"(r) : "v"(lo), "v"(hi)); return r; }
__device__ __forceinline__ bf16x8 load8(const bf16_t* p) { return *reinterpret_cast<const bf16x8*>(p); }
__device__ __forceinline__ void mask_tile(f32x16& p0, f32x16& p1, int dq) {
    const float NEG = -__builtin_inff();
#pragma unroll
    for (int r = 0; r < 16; ++r) { const int c = (r & 3) + 8 * (r >> 2); if (dq - c < 0) p0[r] = NEG; if (dq - c - 32 < 0) p1[r] = NEG; }
}
__device__ __forceinline__ void partialSM(f32x16& p0, f32x16& p1, float& m_reg, float& mn, float& alpha) {
    float pmax = p0[0];
#pragma unroll
    for (int r = 1; r < 16; ++r) pmax = fmaxf(pmax, p0[r]);
#pragma unroll
    for (int r = 0; r < 16; ++r) pmax = fmaxf(pmax, p1[r]);
    { auto rr = __builtin_amdgcn_permlane32_swap(__float_as_uint(pmax), __float_as_uint(pmax), false, false);
      pmax = fmaxf(__uint_as_float(rr[0]), __uint_as_float(rr[1])); }
    constexpr float C2 = 1.4426950408889634f * ATT_SCALE;
    if (__builtin_expect(__all((pmax - m_reg) * ATT_SCALE <= THR), 1)) { mn = m_reg; alpha = 1.f; }
    else { mn = fmaxf(m_reg, pmax); alpha = __builtin_amdgcn_exp2f((m_reg - mn) * C2); m_reg = mn; }
    const float mnL = -mn * C2;
#pragma unroll
    for (int r = 0; r < 16; ++r) p0[r] = fmaf(p0[r], C2, mnL);
#pragma unroll
    for (int r = 0; r < 16; ++r) p1[r] = fmaf(p1[r], C2, mnL);
#pragma unroll
    for (int r = 0; r < 16; ++r) p0[r] = __builtin_amdgcn_exp2f(p0[r]);
}
__device__ __forceinline__ void finishSM(f32x16& p0, f32x16& p1, float alpha, float& l_reg, bf16x8& pa0, bf16x8& pa1, bf16x8& pa2, bf16x8& pa3) {
#pragma unroll
    for (int r = 0; r < 16; ++r) p1[r] = __builtin_amdgcn_exp2f(p1[r]);
    float ps = 0;
#pragma unroll
    for (int r = 0; r < 16; ++r) ps += p0[r];
#pragma unroll
    for (int r = 0; r < 16; ++r) ps += p1[r];
    { auto rr = __builtin_amdgcn_permlane32_swap(__float_as_uint(ps), __float_as_uint(ps), false, false);
      ps = __uint_as_float(rr[0]) + __uint_as_float(rr[1]); }
    l_reg = l_reg * alpha + ps;
#define PK4(P, B_, OUT) do { unsigned a0 = cvtpk(P[B_+0], P[B_+1]), a1 = cvtpk(P[B_+2], P[B_+3]);                          \
        unsigned b0 = cvtpk(P[B_+4], P[B_+5]), b1 = cvtpk(P[B_+6], P[B_+7]);                                             \
        auto r0 = __builtin_amdgcn_permlane32_swap(a0, b0, false, false); auto r1 = __builtin_amdgcn_permlane32_swap(a1, b1, false, false); \
        u32x4 w = {r0[0], r1[0], r0[1], r1[1]}; OUT = *reinterpret_cast<bf16x8*>(&w); } while (0)
    PK4(p0, 0, pa0); PK4(p0, 8, pa1); PK4(p1, 0, pa2); PK4(p1, 8, pa3);
#undef PK4
}
template <int KB>
__device__ __forceinline__ void qkt(f32x16& p0, f32x16& p1, const LAS char* lds, int r32, int hi, const bf16x8* qr, const LAS char* qrb) {
    p0 = f32x16{}; p1 = f32x16{};
    { const LAS char* kbp = lds + OFF_K + KB * SHM_K + KSWZ(r32, hi * 16);
#pragma unroll
    for (int d0 = 0; d0 < 8; ++d0) { const LAS char* a = kbp + d0 * 32;
        const bf16x8 b0 = *reinterpret_cast<const LAS bf16x8*>(a);
        const bf16x8 b1 = *reinterpret_cast<const LAS bf16x8*>(a + 32 * 272);
        p0 = __builtin_amdgcn_mfma_f32_32x32x16_bf16(b0, qr[d0], p0, 0, 0, 0);
        p1 = __builtin_amdgcn_mfma_f32_32x32x16_bf16(b1, qr[d0], p1, 0, 0, 0); } }
    { const LAS char* rb = lds + OFF_R + KB * SHM_R + RSWZ(r32, hi * 16);
#pragma unroll
    for (int d0 = 0; d0 < 4; ++d0) { const LAS char* a = rb + d0 * 32;
        const bf16x8 b0 = *reinterpret_cast<const LAS bf16x8*>(a);
        const bf16x8 b1 = *reinterpret_cast<const LAS bf16x8*>(a + 32 * 144);
        const bf16x8 qv = *reinterpret_cast<const LAS bf16x8*>(qrb + d0 * 1024);
        p0 = __builtin_amdgcn_mfma_f32_32x32x16_bf16(b0, qv, p0, 0, 0, 0);
        p1 = __builtin_amdgcn_mfma_f32_32x32x16_bf16(b1, qv, p1, 0, 0, 0); } }
}
template <int VB>
__device__ __forceinline__ void pv_tile(f32x16* o, int vb0, bf16x8 pa0, bf16x8 pa1, bf16x8 pa2, bf16x8 pa3) {
#define TRRD(dst, off) asm volatile("ds_read_b64_tr_b16 %0, %1 offset:%2" : "=&v"(dst) : "v"(vb0), "i"(off) : "memory")
#define PV_D0(d0) do { s16x4 l0, l1, l2, l3, h0, h1, h2, h3; constexpr int b_ = OFF_V + VB * SHM_V + v_rd_off(d0, 0, 0); \
        TRRD(l0, b_); TRRD(h0, b_ + 2048); TRRD(l1, b_ + 4096); TRRD(h1, b_ + 6144); TRRD(l2, b_ + 8192); TRRD(h2, b_ + 10240); TRRD(l3, b_ + 12288); TRRD(h3, b_ + 14336); \
        asm volatile("s_waitcnt lgkmcnt(0)" ::: "memory"); SBAR();   \
        o[d0] = __builtin_amdgcn_mfma_f32_32x32x16_bf16(pa0, (bf16x8){l0[0], l0[1], l0[2], l0[3], h0[0], h0[1], h0[2], h0[3]}, o[d0], 0, 0, 0);   \
        o[d0] = __builtin_amdgcn_mfma_f32_32x32x16_bf16(pa1, (bf16x8){l1[0], l1[1], l1[2], l1[3], h1[0], h1[1], h1[2], h1[3]}, o[d0], 0, 0, 0);   \
        o[d0] = __builtin_amdgcn_mfma_f32_32x32x16_bf16(pa2, (bf16x8){l2[0], l2[1], l2[2], l2[3], h2[0], h2[1], h2[2], h2[3]}, o[d0], 0, 0, 0);   \
        o[d0] = __builtin_amdgcn_mfma_f32_32x32x16_bf16(pa3, (bf16x8){l3[0], l3[1], l3[2], l3[3], h3[0], h3[1], h3[2], h3[3]}, o[d0], 0, 0, 0); } while (0)
    PV_D0(0); PV_D0(1); PV_D0(2); PV_D0(3);
#undef PV_D0
#undef TRRD
}
struct BlockRef { int bl, h, qb; };
struct Bases { const bf16_t* Q; const bf16_t* KV; const bf16_t* KPE; const bf16_t* P; bf16_t* Y; };
#define R_K(r) (B.KV + (size_t)(r).bl * SEQ * NKV + (r).h * 256)
#define R_V(r) (B.KV + (size_t)(r).bl * SEQ * NKV + (r).h * 256 + 128)
#define R_R(r) (B.KPE + (size_t)(r).bl * SEQ * 64)
#define R_QN(r) (B.Q + ((size_t)(r).bl * SEQ + (size_t)(r).qb * QB) * NQ + (r).h * 128)
#define R_QR(r) (B.Q + ((size_t)(r).bl * SEQ + (size_t)(r).qb * QB) * NQ + 1024 + ((r).h >> 2) * 256 + ((r).h & 3) * 32)
#define R_Z(r) (B.P + ((size_t)(r).bl * SEQ + (size_t)(r).qb * QB) * NRC + R_MZ + (r).h * 128)
#define R_O(r) (B.Y + ((size_t)(r).bl * SEQ + (size_t)(r).qb * QB) * 1024 + (r).h * 128)
struct Seam { bf16x8 qr[8]; bf16x8 st_v0, st_v1, st_k0, st_k1, st_r; };
#define VMW() asm volatile("s_waitcnt vmcnt(0)" ::: "memory")
#define VMWN(n) asm volatile("s_waitcnt vmcnt(%0)" :: "i"(n) : "memory")
#define LDU8(ubase, off) (*(const bf16x8*)((const char*)(ubase) + (off)))
#define SLOAD_H(Kp, Vp, Rp, k0) do { int t_ = tid; LAUNDER(t_); const unsigned kvoff_ = (unsigned)((t_ >> 4) * NKV + (t_ & 15) * 8) * 2u, roff_ = (unsigned)((t_ >> 3) * 64 + (t_ & 7) * 8) * 2u; \
                         S.st_v0 = LDU8((Vp) + (size_t)(k0) * NKV, kvoff_); S.st_v1 = LDU8((Vp) + (size_t)((k0) + 32) * NKV, kvoff_); \
                         S.st_k0 = LDU8((Kp) + (size_t)(k0) * NKV, kvoff_); S.st_k1 = LDU8((Kp) + (size_t)((k0) + 32) * NKV, kvoff_); \
                         S.st_r = LDU8((Rp) + (size_t)(k0) * 64, roff_); } while (0)
#define SWRITE_HK(bf) do { int t_ = tid; LAUNDER(t_); const int kws_ = KSWZ(t_ >> 4, (t_ & 15) * 16), rws_ = RSWZ(t_ >> 3, (t_ & 7) * 16); \
                           *(LAS bf16x8*)(lds + OFF_K + (bf) * SHM_K + kws_) = S.st_k0; *(LAS bf16x8*)(lds + OFF_K + (bf) * SHM_K + kws_ + 32 * 272) = S.st_k1; \
                           *(LAS bf16x8*)(lds + OFF_R + (bf) * SHM_R + rws_) = S.st_r; } while (0)
#define SWRITE_HV(bf) do { int t_ = tid; LAUNDER(t_); const int vst0_ = v_st(t_ >> 4, (t_ & 15) * 8), vst1_ = v_st(32 + (t_ >> 4), (t_ & 15) * 8); \
                           *(LAS bf16x8*)(lds + OFF_V + (bf) * SHM_V + vst0_) = S.st_v0; *(LAS bf16x8*)(lds + OFF_V + (bf) * SHM_V + vst1_) = S.st_v1; } while (0)
#define SWRITE_H(bf) do { SWRITE_HV(bf); SWRITE_HK(bf); } while (0)
#define QOFF_ ({ int t_ = tid; LAUNDER(t_); (unsigned)((t_ & 31) * NQ + ((t_ >> 5) & 1) * 8) * 2u; })
#define QLOAD(B_) do { const bf16_t* qn_ = R_QN(B_) + (size_t)(wid * QBLK) * NQ; const unsigned qoff_ = QOFF_; \
        _Pragma("unroll") for (int d0 = 0; d0 < 8; ++d0) S.qr[d0] = LDU8(qn_ + d0 * 16, qoff_); } while (0)
#define QLOAD_R(B_) const bf16_t* qr_ = R_QR(B_) + (size_t)(wid * QBLK) * NQ; const unsigned qoffr_ = QOFF_; \
        const bf16x8 qt0 = LDU8(qr_, qoffr_), qt1 = LDU8(qr_ + 16, qoffr_), qt2 = LDU8(qr_ + 128, qoffr_), qt3 = LDU8(qr_ + 144, qoffr_)
#define QWRITE_R() do { *(LAS bf16x8*)(qrb) = qt0; *(LAS bf16x8*)(qrb + 1024) = qt1; *(LAS bf16x8*)(qrb + 2048) = qt2; *(LAS bf16x8*)(qrb + 3072) = qt3; } while (0)
__device__ __forceinline__ void attn_prime(const Bases& B, const BlockRef& cur, LAS char* lds, Seam& S, int tid) {
    const int wid = __builtin_amdgcn_readfirstlane(tid >> 6), lane = tid & 63, r32 = lane & 31, hi = lane >> 5;
    LAS char* qrb = lds + OFF_QR + wid * 4096 + lane * 16;
    QLOAD(cur); QLOAD_R(cur);
    SLOAD_H(R_K(cur), R_V(cur), R_R(cur), 0); VMW(); SWRITE_HK(0); QWRITE_R();
    __syncthreads();
}
__device__ __forceinline__ void attn_block(const Bases& B, const BlockRef& cur, const BlockRef& nxt, LAS char* lds, Seam& S, int tid) {
    const int wid = __builtin_amdgcn_readfirstlane(tid >> 6), lane = tid & 63, r32 = lane & 31, hi = lane >> 5;
    const int P0 = cur.qb * QB, NT = (P0 + QB - 1) / KVBLK + 1;
    const int qlo = P0 + wid * QBLK, qm = qlo + r32 - 4 * hi;
    LAS float* ws = (LAS float*)(lds + OFF_WS) + wid * 64; LAS float* li_l = ws; LAS float* al_l = ws + 32;
    float m_reg = -1e30f, l_reg = 0; f32x16 o[4] = {};
    const int vb0 = (int)(unsigned)(uintptr_t)lds + v_rd_base(lane);
    LAS char* qrb = lds + OFF_QR + wid * 4096 + lane * 16;
#define Kh R_K(cur)
#define Vh R_V(cur)
#define Rh R_R(cur)
#define RESC(a) do { if (__any((a) < 1.f)) { if (hi == 0) al_l[r32] = (a); asm volatile("s_waitcnt lgkmcnt(0)" ::: "memory");              \
                     for (int d_ = 0; d_ < 4; ++d_) for (int r = 0; r < 16; ++r) o[d_][r] *= al_l[crow(r, hi)]; } } while (0)
#define KBASE(t) ((t) * KVBLK)
#define MASKT(P0_, P1_, t) do { const int kb_ = KBASE(t); if (kb_ + KVBLK - 1 > qlo) mask_tile(P0_, P1_, qm - kb_); } while (0)
    f32x16 pA0, pA1, pB0, pB1; float mnA, mnB, alA, alB; bf16x8 pa0, pa1, pa2, pa3;
    SWRITE_HV(0); SBAR();
    if (NT > 1) { SLOAD_H(Kh, Vh, Rh, KBASE(1)); }
    SBAR(); qkt<0>(pA0, pA1, lds, r32, hi, S.qr, qrb);
    MASKT(pA0, pA1, 0); partialSM(pA0, pA1, m_reg, mnA, alA);
    if (NT > 1) { VMW(); SWRITE_H(1); }
    __syncthreads();
    int vr = 0;
#define HALF_STEP(PX0, PX1, mnX, alX, PY0, PY1, alY, t, KB, SB) do {                                                          \
        SBAR(); qkt<KB>(PX0, PX1, lds, r32, hi, S.qr, qrb);                                                                   \
        finishSM(PY0, PY1, alY, l_reg, pa0, pa1, pa2, pa3); SBAR();                                                           \
        if ((t) + 1 < NT) { SLOAD_H(Kh, Vh, Rh, KBASE((t) + 1)); SBAR(); }                                                    \
        pv_tile<0>(o, vb0 + vr * SHM_V, pa0, pa1, pa2, pa3); MASKT(PX0, PX1, (t)); partialSM(PX0, PX1, m_reg, mnX, alX);      \
        { const int vw = vr == 0 ? 2 : vr - 1;                                                                                \
          if ((t) + 1 < NT) { VMW(); SWRITE_HK(SB); SWRITE_HV(vw); } }                                                        \
        RESC(alX); __syncthreads(); vr = vr == 2 ? 0 : vr + 1; } while (0)
    for (int t = 1; t + 1 < NT; t += 2) {
        HALF_STEP(pB0, pB1, mnB, alB, pA0, pA1, alA, t, 1, 0);
        HALF_STEP(pA0, pA1, mnA, alA, pB0, pB1, alB, t + 1, 0, 1);
    }
    const bool even = (NT & 1) == 0;
    if (even) { SBAR(); qkt<1>(pB0, pB1, lds, r32, hi, S.qr, qrb); SBAR(); }
    SLOAD_H(R_K(nxt), R_V(nxt), R_R(nxt), 0); SBAR();
    QLOAD(nxt);
    SBAR();
    finishSM(pA0, pA1, alA, l_reg, pa0, pa1, pa2, pa3); SBAR();
    pv_tile<0>(o, vb0 + vr * SHM_V, pa0, pa1, pa2, pa3);
    if (even) { MASKT(pB0, pB1, NT - 1); partialSM(pB0, pB1, m_reg, mnB, alB); __syncthreads(); RESC(alB);
        finishSM(pB0, pB1, alB, l_reg, pa0, pa1, pa2, pa3); SBAR(); pv_tile<0>(o, vb0 + (vr == 2 ? 0 : vr + 1) * SHM_V, pa0, pa1, pa2, pa3); }
    SBAR(); VMWN(8); SWRITE_HK(0); SBAR();
    QLOAD_R(nxt);
    if (hi == 0) li_l[r32] = l_reg; asm volatile("s_waitcnt lgkmcnt(0)" ::: "memory");
    bf16_t* Ow = R_O(cur) + (size_t)(wid * QBLK) * 1024; const bf16_t* Zw = R_Z(cur) + (size_t)(wid * QBLK) * NRC;
    int l_ = tid; LAUNDER(l_); const int hi_ = (l_ >> 5) & 1, r32_ = l_ & 31;
    const unsigned zoff = (unsigned)(4 * hi_ * NRC + r32_) * 2u, ooff = (unsigned)(4 * hi_ * 1024 + r32_) * 2u;
#pragma unroll
    for (int r = 0; r < 16; ++r) { const int rc = (r & 3) + 8 * (r >> 2); const float rli = __builtin_amdgcn_rcpf(li_l[rc + 4 * hi]);
#pragma unroll
        for (int d0 = 0; d0 < 4; ++d0) { const float z = bf2f(*(const bf16_t*)((const char*)(Zw + (size_t)rc * NRC + d0 * 32) + zoff)); const float v = o[d0][r] * rli * siluf_(z);
            const float vn = __shfl_xor(v, 1);
            if ((r32 & 1) == 0) *(unsigned*)((char*)(Ow + (size_t)rc * 1024 + d0 * 32) + ooff) = cvtpk(v, vn); }
        if ((r & 3) == 3) asm volatile("" ::: "memory"); }
    QWRITE_R();
    __syncthreads();
#undef Kh
#undef Vh
#undef Rh
#undef RESC
#undef KBASE
#undef MASKT
#undef HALF_STEP
}
constexpr int NQUE = 8, BHQ = BPP * 8 / NQUE, QPER = BHQ * 32, OFF_QW = ATT_LDS;
__device__ __forceinline__ int unit_bh(int code) { const int q = code / QPER, v = code % QPER; return q * BHQ + v % BHQ; }
__device__ __forceinline__ BlockRef make_ref(int code) { BlockRef r; const int bh = unit_bh(code), a = code % QPER; r.bl = bh >> 3; r.h = bh & 7; r.qb = 31 - a / BHQ; return r; }
__device__ __forceinline__ int fetch_unit(unsigned* ctrs, LAS char* lds, int tid, unsigned x) {
    if (tid == 0) { volatile LAS unsigned* w = (volatile LAS unsigned*)(lds + OFF_QW); unsigned k = w[1]; int code = -1;
        while (k < (unsigned)NQUE) { const unsigned q = (x + k) & (NQUE - 1); const unsigned v = __hip_atomic_fetch_add(ctrs + q, 1u, __ATOMIC_RELAXED, __HIP_MEMORY_SCOPE_AGENT);
            if (v < (unsigned)QPER) { code = (int)(q * QPER + v); break; } ++k; }
        w[1] = k; w[0] = (unsigned)code; }
    __syncthreads();
    const int u = (int)*(volatile LAS unsigned*)(lds + OFF_QW);
    return __builtin_amdgcn_readfirstlane(u);
}
#undef KSWZ
#undef RSWZ
#undef SLOAD_H
#undef SWRITE_HK
#undef SWRITE_HV
#undef SWRITE_H
#undef QLOAD
#undef QLOAD_R
#undef QWRITE_R
#undef VMW
#undef VMWN
}


namespace hg {
constexpr int QI_S = 272, KT_S = 144, A_S = 144, ST_S = 272;
constexpr int OFF_QI = 0, OFF_KI = OFF_QI + 64 * QI_S, OFF_KOT = OFF_KI + 64 * QI_S, OFF_VT = OFF_KOT + 128 * KT_S, OFF_A = OFF_VT + 128 * KT_S,
              OFF_ST = OFF_A + 64 * A_S, OFF_SEG = OFF_ST + 128 * ST_S, OFF_DEC = OFF_SEG + 2048, OFF_SSQ = OFF_DEC + 512, HG_LDS = OFF_SSQ + 512;
#define MFMA16(a, b, c) __builtin_amdgcn_mfma_f32_16x16x32_bf16(a, b, c, 0, 0, 0)
__device__ __forceinline__ void hgrn_unit(const bf16_t* P, bf16_t* Y, const float* lb, const float* hgn, LAS unsigned char* lds, int bl, int h, int tid) {
    const int lane = tid & 63, w = __builtin_amdgcn_readfirstlane(tid >> 6), fr = lane & 15, fq = lane >> 4;
    const int k = tid & 127, seg = tid >> 7, tt = w & 3, vh = w >> 2;
    const float lbk = lb[h * 128 + k];
    for (int i = tid; i < 128 * ST_S / 16; i += 512) *(LAS u32x4*)(lds + OFF_ST + i * 16) = (u32x4){0u, 0u, 0u, 0u};
    f32x4 S[8];
#pragma unroll
    for (int i = 0; i < 8; ++i) S[i] = (f32x4){0.f, 0.f, 0.f, 0.f};
    const bf16_t* Pb = P + (size_t)bl * SEQ * NHC + h * 128;
    unsigned short rq[16], rf[16], ri[16];
    { const bf16_t* p = Pb + (size_t)(seg * 16) * NHC + k;
#pragma unroll
      for (int j = 0; j < 16; ++j) { rq[j] = p[(size_t)j * NHC + C_HQ]; rf[j] = p[(size_t)j * NHC + C_HF]; ri[j] = p[(size_t)j * NHC + C_HI]; } }
    LAS float* segs = (LAS float*)(lds + OFF_SEG); LAS float* decs = (LAS float*)(lds + OFF_DEC); LAS float* ssq = (LAS float*)(lds + OFF_SSQ);
    const float oml = 1.f - lbk; constexpr float L2E = 1.4426950408889634f;
    float c[16], om[16]; f32x4 o[4]; u32x2 rz[4];
#define HG_A1() do { float run = 0.f; _Pragma("unroll") for (int j = 0; j < 16; ++j) { const float sg = __builtin_amdgcn_rcpf(1.f + __builtin_amdgcn_exp2f(-L2E * bf2f(rf[j]))); \
            const float f = fmaf(oml, sg, lbk); om[j] = fmaf(-oml, sg, oml); run += __builtin_amdgcn_logf(f); c[j] = run; } segs[seg * 128 + k] = run; } while (0)
#define HG_OUT(t0_) do { const float tot = ssq[tt * 16 + fr] + ssq[64 + tt * 16 + fr]; const float rn = rsqrtf(tot * (1.f / 128.f) + EPS); \
          bf16_t* yp = Y + ((size_t)bl * SEQ + (t0_) + tt * 16 + fr) * 1024 + h * 128; \
          _Pragma("unroll") for (int i = 0; i < 4; ++i) { const int v0 = (vh * 4 + i) * 16 + 4 * fq; const f32x4 g4 = *(const f32x4*)(hgn + v0); \
              const float y0 = o[i][0] * rn * g4[0] * siluf_(bflo(rz[i].x)), y1 = o[i][1] * rn * g4[1] * siluf_(bfhi(rz[i].x)); \
              const float y2 = o[i][2] * rn * g4[2] * siluf_(bflo(rz[i].y)), y3 = o[i][3] * rn * g4[3] * siluf_(bfhi(rz[i].y)); \
              *(u32x2*)(yp + v0) = (u32x2){cvtpk_s(y0, y1), cvtpk_s(y2, y3)}; } } while (0)
    HG_A1();
#pragma unroll 1
    for (int n = 0; n < SEQ / 64; ++n) {
        const int t0 = n * 64;
        __syncthreads();
        if (n > 0) HG_OUT(t0 - 64);
#pragma unroll
        for (int i = 0; i < 4; ++i) rz[i] = *(const u32x2*)(Pb + (size_t)(t0 + tt * 16 + fr) * NHC + C_HZ + (vh * 4 + i) * 16 + 4 * fq);
        { const float s0 = segs[k], s1 = segs[128 + k], s2 = segs[256 + k], s3 = segs[384 + k];
          const float offs = (seg > 0 ? s0 : 0.f) + (seg > 1 ? s1 : 0.f) + (seg > 2 ? s2 : 0.f), total = (s0 + s1) + (s2 + s3);
          unsigned ko[8], vv[8];
          const float dk = __builtin_amdgcn_exp2f(total);
#pragma unroll
          for (int j = 0; j < 16; j += 2) {
              const float e0 = __builtin_amdgcn_exp2f(offs + c[j]), e1 = __builtin_amdgcn_exp2f(offs + c[j + 1]);
              const float r0 = __builtin_amdgcn_rcpf(e0), r1 = __builtin_amdgcn_rcpf(e1);
              const float hq0 = bf2f(rq[j]), hq1 = bf2f(rq[j + 1]);
              const float q0 = hq0 * e0 * __builtin_amdgcn_rcpf(1.f + __builtin_amdgcn_exp2f(-L2E * hq0)), q1 = hq1 * e1 * __builtin_amdgcn_rcpf(1.f + __builtin_amdgcn_exp2f(-L2E * hq1));
              const unsigned qw = cvtpk_s(q0, q1);
              const float ki0 = om[j] * r0, ki1 = om[j + 1] * r1;
              const unsigned kw = cvtpk_s(ki0, ki1);
              const int t = seg * 16 + j;
              *(LAS bf16_t*)(lds + OFF_QI + t * QI_S + k * 2) = (bf16_t)(qw & 0xffffu); *(LAS bf16_t*)(lds + OFF_QI + (t + 1) * QI_S + k * 2) = (bf16_t)(qw >> 16);
              *(LAS bf16_t*)(lds + OFF_KI + t * QI_S + k * 2) = (bf16_t)(kw & 0xffffu); *(LAS bf16_t*)(lds + OFF_KI + (t + 1) * QI_S + k * 2) = (bf16_t)(kw >> 16);
              ko[j >> 1] = cvtpk_s(ki0 * dk, ki1 * dk);
              vv[j >> 1] = (unsigned)ri[j] | ((unsigned)ri[j + 1] << 16);
          }
          *(LAS u32x4*)(lds + OFF_KOT + k * KT_S + seg * 32) = (u32x4){ko[0], ko[1], ko[2], ko[3]}; *(LAS u32x4*)(lds + OFF_KOT + k * KT_S + seg * 32 + 16) = (u32x4){ko[4], ko[5], ko[6], ko[7]};
          *(LAS u32x4*)(lds + OFF_VT + k * KT_S + seg * 32) = (u32x4){vv[0], vv[1], vv[2], vv[3]}; *(LAS u32x4*)(lds + OFF_VT + k * KT_S + seg * 32 + 16) = (u32x4){vv[4], vv[5], vv[6], vv[7]};
          if (seg == 0) decs[k] = dk;
        }
        { const int tn = (n + 1 < SEQ / 64 ? t0 + 64 : t0) + seg * 16; const bf16_t* p = Pb + (size_t)tn * NHC + k;
#pragma unroll
          for (int j = 0; j < 16; ++j) { rq[j] = p[(size_t)j * NHC + C_HQ]; rf[j] = p[(size_t)j * NHC + C_HF]; ri[j] = p[(size_t)j * NHC + C_HI]; } }
        __syncthreads();
        bf16x8 qf[4];
#pragma unroll
        for (int ks = 0; ks < 4; ++ks) qf[ks] = *(const LAS bf16x8*)(lds + OFF_QI + (tt * 16 + fr) * QI_S + (ks * 32 + 8 * fq) * 2);
#pragma unroll
        for (int si = 0; si < 2; ++si) { const int st = 2 * vh + si; f32x4 acc = (f32x4){0.f, 0.f, 0.f, 0.f};
            if (st <= tt) {
#pragma unroll
                for (int ks = 0; ks < 4; ++ks) { const bf16x8 kf = *(const LAS bf16x8*)(lds + OFF_KI + (st * 16 + fr) * QI_S + (ks * 32 + 8 * fq) * 2); acc = MFMA16(kf, qf[ks], acc); } }
            const int tg = tt * 16 + fr, sg = st * 16 + 4 * fq;
#pragma unroll
            for (int r = 0; r < 4; ++r) if (sg + r > tg) acc[r] = 0.f;
            *(LAS u32x2*)(lds + OFF_A + tg * A_S + sg * 2) = (u32x2){cvtpk_s(acc[0], acc[1]), cvtpk_s(acc[2], acc[3])}; }
#pragma unroll
        for (int i = 0; i < 4; ++i) { o[i] = (f32x4){0.f, 0.f, 0.f, 0.f}; const int vt = vh * 4 + i;
#pragma unroll
            for (int ks = 0; ks < 4; ++ks) { const bf16x8 sf = *(const LAS bf16x8*)(lds + OFF_ST + (vt * 16 + fr) * ST_S + (ks * 32 + 8 * fq) * 2); o[i] = MFMA16(sf, qf[ks], o[i]); } }
        __syncthreads();
        { bf16x8 af[2];
#pragma unroll
          for (int ks = 0; ks < 2; ++ks) af[ks] = *(const LAS bf16x8*)(lds + OFF_A + (tt * 16 + fr) * A_S + (ks * 32 + 8 * fq) * 2);
#pragma unroll
          for (int i = 0; i < 4; ++i) { const int vt = vh * 4 + i;
#pragma unroll
              for (int ks = 0; ks < 2; ++ks) { const bf16x8 vf = *(const LAS bf16x8*)(lds + OFF_VT + (vt * 16 + fr) * KT_S + (ks * 32 + 8 * fq) * 2); o[i] = MFMA16(vf, af[ks], o[i]); } } }
        { const f32x4 dec4 = *(const LAS f32x4*)(lds + OFF_DEC + (w * 16 + 4 * fq) * 4);
          bf16x8 kof[2];
#pragma unroll
          for (int ks = 0; ks < 2; ++ks) kof[ks] = *(const LAS bf16x8*)(lds + OFF_KOT + (w * 16 + fr) * KT_S + (ks * 32 + 8 * fq) * 2);
#pragma unroll
          for (int vt = 0; vt < 8; ++vt) { S[vt] = S[vt] * dec4;
#pragma unroll
              for (int ks = 0; ks < 2; ++ks) { const bf16x8 vf = *(const LAS bf16x8*)(lds + OFF_VT + (vt * 16 + fr) * KT_S + (ks * 32 + 8 * fq) * 2); S[vt] = MFMA16(kof[ks], vf, S[vt]); }
              *(LAS u32x2*)(lds + OFF_ST + (vt * 16 + fr) * ST_S + (w * 16 + 4 * fq) * 2) = (u32x2){cvtpk_s(S[vt][0], S[vt][1]), cvtpk_s(S[vt][2], S[vt][3])}; } }
        { float ss = 0.f;
#pragma unroll
          for (int i = 0; i < 4; ++i) ss += (o[i][0] * o[i][0] + o[i][1] * o[i][1]) + (o[i][2] * o[i][2] + o[i][3] * o[i][3]);
          ss += __shfl_xor(ss, 16); ss += __shfl_xor(ss, 32);
          if (fq == 0) ssq[vh * 64 + tt * 16 + fr] = ss; }
        HG_A1();
    }
    __syncthreads();
    HG_OUT(SEQ - 64);
    __syncthreads();
#undef HG_A1
#undef HG_OUT
}
#undef MFMA16
}

#define XB_TMO      128
#define XB_XCNT(j)  (256  + 64 * (j))
#define XB_XSUB(j)  (1280 + 64 * (j))
#define XB_XGEN(j)  (2304 + 64 * (j))
#define XB_TOP      3328
#define XB_TOPGEN   3392
#define XCD_BAR_WORDS 3456
#define XB_SPIN_CAP (1u << 20)
__device__ __forceinline__ unsigned xb_ld(unsigned* p)              { return __hip_atomic_load(p, __ATOMIC_RELAXED, __HIP_MEMORY_SCOPE_AGENT); }
__device__ __forceinline__ unsigned xb_add(unsigned* p, unsigned v) { return __hip_atomic_fetch_add(p, v, __ATOMIC_RELAXED, __HIP_MEMORY_SCOPE_AGENT); }
__device__ __forceinline__ unsigned xb_xcc_id() { return (unsigned)__builtin_amdgcn_s_getreg((3 << 11) | 20) & 0xFu; }
#define XB_SPIN(cond, bar) do { unsigned _sp = 0; while (cond) { __builtin_amdgcn_s_sleep(1); \
    if ((++_sp & 255u) == 0u) { if (xb_ld(&(bar)[XB_TMO])) break; if (_sp > XB_SPIN_CAP) { atomicAdd(&(bar)[XB_TMO], 1u); break; } } } } while (0)
struct XcdBarrier { unsigned* bar; unsigned x; volatile LAS unsigned* st; };
__device__ __forceinline__ XcdBarrier xcd_barrier_post(unsigned* bar, volatile LAS unsigned* st) {
    XcdBarrier b; b.bar = bar; b.x = xb_xcc_id(); b.st = st;
    if (threadIdx.x == 0) (void)xb_add(&bar[XB_XCNT(b.x)], 1u);
    return b;
}
__device__ __forceinline__ void xcd_barrier_complete(unsigned* bar, unsigned x, unsigned& nloc, unsigned& nx) {
    const unsigned G = gridDim.x * gridDim.y * gridDim.z;
    unsigned sum, cnt, mine, sp = 0u;
    for (;;) {
        sum = 0u; cnt = 0u; mine = 0u;
#pragma unroll
        for (unsigned j = 0; j < 16; ++j) { const unsigned c = xb_ld(&bar[XB_XCNT(j)]); sum += c; cnt += (c > 0u) ? 1u : 0u; mine = (j == x) ? c : mine; }
        if (sum == G) break;
        __builtin_amdgcn_s_sleep(1);
        if ((++sp & 255u) == 0u) { if (xb_ld(&bar[XB_TMO])) break; if (sp > XB_SPIN_CAP) { atomicAdd(&bar[XB_TMO], 1u); break; } }
    }
    nloc = mine > 0u ? mine : 1u; nx = cnt > 0u ? cnt : 1u;
}
__device__ __forceinline__ void xcd_barrier(unsigned* bar, volatile LAS unsigned* st) {
    asm volatile("s_waitcnt vmcnt(0)" ::: "memory");
    __syncthreads();
    if (threadIdx.x == 0) {
        const unsigned x = xb_xcc_id();
        __builtin_amdgcn_s_waitcnt(0);
        unsigned nloc = st[0], nx = st[1];
        if (nloc == 0u) { xcd_barrier_complete(bar, x, nloc, nx); st[0] = nloc; st[1] = nx; }
        const unsigned old = xb_add(&bar[XB_XSUB(x)], 1u);
        const unsigned gen = old / nloc;
        if (old + 1u == (gen + 1u) * nloc) {
            __builtin_amdgcn_fence(__ATOMIC_RELEASE, "agent");
            asm volatile("s_waitcnt vmcnt(0)" ::: "memory");
            const unsigned og = xb_add(&bar[XB_TOP], 1u);
            const unsigned tg = og / nx;
            if (og + 1u == (tg + 1u) * nx) xb_add(&bar[XB_TOPGEN], 1u);
            else XB_SPIN(xb_ld(&bar[XB_TOPGEN]) == tg, bar);
            __builtin_amdgcn_fence(__ATOMIC_ACQUIRE, "agent");
            xb_add(&bar[XB_XGEN(x)], 1u);
            asm volatile("s_waitcnt vmcnt(0)" ::: "memory");
        } else {
            XB_SPIN(xb_ld(&bar[XB_XGEN(x)]) == gen, bar);
            __builtin_amdgcn_fence(__ATOMIC_ACQUIRE, "agent");
            asm volatile("s_waitcnt vmcnt(0)" ::: "memory");
        }
    }
    __syncthreads();
}

__device__ __forceinline__ const void* karg_ptr(int byte_off) {
    const __attribute__((address_space(1))) void* p;
    const unsigned long long kpi = (unsigned long long)__builtin_amdgcn_kernarg_segment_ptr();
    const unsigned lo = __builtin_amdgcn_readfirstlane((unsigned)kpi), hi = __builtin_amdgcn_readfirstlane((unsigned)(kpi >> 32));
    const unsigned long long k2 = ((unsigned long long)hi << 32) | lo;
    asm volatile("s_load_dwordx2 %0, %1, %2\n\ts_waitcnt lgkmcnt(0)" : "=s"(p) : "s"(k2), "n"(byte_off) : "memory"); return (const void*)p;
}
static_assert(offsetof(Args, out) == 112 && offsetof(Args, ws) == 120, "kernarg offsets");
__global__ void __launch_bounds__(512, 2) mega_fwd(Args a) {
    extern __shared__ __attribute__((aligned(16))) unsigned char lds_raw[];
    LAS unsigned char* lds = (LAS unsigned char*)lds_raw;
    cg::grid_group grid = cg::this_grid();
    const int wave = wave_id_s();
#define TIDV (wave * 64 + lane_id_v())
#define BAR_ST ((volatile LAS unsigned*)(lds + LDS_BYTES - 64))
#define BAR_W ((unsigned*)((unsigned char*)karg_ptr(120) + WS_BAR))
#define GRID_BAR() xcd_barrier(BAR_W, BAR_ST)
    if (threadIdx.x == 0) { BAR_ST[0] = 0u; BAR_ST[1] = 0u; }
    if (blockIdx.x == 0) { unsigned* bw = BAR_W; for (int i = (int)threadIdx.x; i < XCD_BAR_WORDS; i += 512) bw[i] = 0u; }
    __syncthreads();
    const int G = gridDim.x, gw = blockIdx.x * 8 + wave, NGW = G * 8;
#define IN_(i) ((const float*)karg_ptr(8 * (i)))
#define x_in IN_(0)
#define norm_g IN_(1)
#define w_in IN_(2)
#define b_gate IN_(3)
#define lb_logits IN_(4)
#define hg_norm_g IN_(5)
#define q_a_g IN_(6)
#define w_uq IN_(7)
#define kv_a_g IN_(8)
#define w_ukv IN_(9)
#define w_pa IN_(10)
#define w_pb IN_(11)
#define w_out IN_(12)
#define final_g IN_(13)
#define OUT_ ((float*)karg_ptr(112))
#define WSL_ ((unsigned char*)karg_ptr(120))
#define WinT ((bf16_t*)(WSL_ + WS_WIN))
#define WuqT ((bf16_t*)(WSL_ + WS_WUQ))
#define WukvT ((bf16_t*)(WSL_ + WS_WUKV))
#define WpT ((bf16_t*)(WSL_ + WS_WP))
#define WoutT ((bf16_t*)(WSL_ + WS_WOUT))
#define cosT ((float*)(WSL_ + WS_COS))
#define sinT ((float*)(WSL_ + WS_SIN))
#define lbv ((float*)(WSL_ + WS_LB))
#define PH ((bf16_t*)(WSL_ + WS_PH))
#define PR ((bf16_t*)(WSL_ + WS_PR))
#define Qb ((bf16_t*)(WSL_ + WS_Q))
#define KVb ((bf16_t*)(WSL_ + WS_KV))
#define KPE ((bf16_t*)(WSL_ + WS_KPE))
#define Ya ((bf16_t*)OUT_)
#define Ybb ((bf16_t*)((unsigned char*)OUT_ + OUT_H_OFF))
#define T1 ((bf16_t*)(WSL_ + WS_T1))
#define MG ((bf16_t*)(WSL_ + WS_MG))
#define Hn ((bf16_t*)((unsigned char*)OUT_ + OUT_H_OFF))

#if !defined(SKIP0)
    for (int rep0_ = 0; rep0_ < REP0; ++rep0_)
    {
        const int lane = lane_id_v(); const int tidp = wave * 64 + lane;
        LAS float* scr = (LAS float*)(lds + wave * 16384);
        constexpr int I_IN = (DM / 64) * (NIN / 32), I_UQ = (QLORA / 64) * (NQ / 32), I_UKV = (KVLORA / 64) * (NKV / 32), I_SQ = (DM / 64) * (DM / 32);
        constexpr int NITEMS = I_IN + I_UQ + I_UKV + 3 * I_SQ;
        for (int it = gw; it < NITEMS; it += NGW) {
            int r = it;
            if (r < I_IN) { transpose_item(w_in, DM, NIN, WinT, 0, nullptr, scr, r, lane); continue; } r -= I_IN;
            if (r < I_UQ) { transpose_item<true>(w_uq, QLORA, NQ, WuqT, 0, q_a_g, scr, r, lane); continue; } r -= I_UQ;
            if (r < I_UKV) { transpose_item(w_ukv, KVLORA, NKV, WukvT, 0, kv_a_g, scr, r, lane); continue; } r -= I_UKV;
            if (r < I_SQ) { transpose_item(w_pa, DM, DM, WpT, 0, nullptr, scr, r, lane); continue; } r -= I_SQ;
            if (r < I_SQ) { transpose_item(w_pb, DM, DM, WpT, 1024, nullptr, scr, r, lane); continue; } r -= I_SQ;
            transpose_item(w_out, DM, DM, WoutT, 0, nullptr, scr, r, lane);
        }
        for (int i = blockIdx.x * 512 + tidp; i < (NINP - NIN) * DM / 8; i += G * 512) *(u32x4*)(WinT + (size_t)NIN * DM + (size_t)i * 8) = (u32x4){0u, 0u, 0u, 0u};
        for (int i = blockIdx.x * 512 + tidp; i < SEQ * 32; i += G * 512) { const int pos = i >> 5, f = i & 31; const float ang = (float)pos * a.inv[f];
            const double r = (double)ang * 0.15915494309189535; const double fr = r - __builtin_rint(r);
            const float rad = (float)(fr * 6.283185307179586);
            cosT[i] = __cosf(rad); sinT[i] = __sinf(rad); }
        if (blockIdx.x == 0 && tidp < 64) ((unsigned*)(WSL_ + WS_CTR))[tidp] = 0u;
        for (int i = blockIdx.x * 512 + tidp; i < 1024; i += G * 512) lbv[i] = sigmoidf_(lb_logits[i] - lb_logits[1024 + i]);
        { const float* xp = x_in; bf16_t* hp = Hn; const f32x4* gp = (const f32x4*)norm_g; f32x4 gg[4];
#pragma unroll
          for (int j = 0; j < 4; ++j) gg[j] = gp[lane + 64 * j];
          for (int m0 = gw * 4; m0 < TTOK; m0 += NGW * 4) {
            f32x4 v[4][4];
#pragma unroll
            for (int r = 0; r < 4; ++r)
#pragma unroll
                for (int j = 0; j < 4; ++j) v[r][j] = ((const f32x4*)(xp + (size_t)(m0 + r) * DM))[lane + 64 * j];
#pragma unroll
            for (int r = 0; r < 4; ++r) { float sq = 0.f;
#pragma unroll
                for (int j = 0; j < 4; ++j) sq += (v[r][j].x * v[r][j].x + v[r][j].y * v[r][j].y) + (v[r][j].z * v[r][j].z + v[r][j].w * v[r][j].w);
                const float rn = rsqrtf(wave_sum(sq) * (1.f / DM) + EPS);
                unsigned long long* o8 = (unsigned long long*)(hp + (size_t)(m0 + r) * DM) + lane;
#pragma unroll
                for (int j = 0; j < 4; ++j) o8[64 * j] = (unsigned long long)pk2(v[r][j].x * rn * gg[j].x, v[r][j].y * rn * gg[j].y) | ((unsigned long long)pk2(v[r][j].z * rn * gg[j].z, v[r][j].w * rn * gg[j].w) << 32); }
          } }
    }
#endif
    grid.sync();
    if (threadIdx.x == 0) (void)xb_add(&BAR_W[XB_XCNT(xb_xcc_id())], 1u);

    { pg8::Gemm g{Hn, WinT, DM, DM, DM}; pg8::SchedPlain S; S.per = 0; S.rep = 1; S.o.init(TH, NHC, G, (int)blockIdx.x);
      pg8::EpiBf16 E{PH, NHC}; pg8::gemm_phase(lds, g, S, E, wave); }
    GRID_BAR();
    if ((int)blockIdx.x < BPP * 8) { const int tidp = TIDV; const int u = (int)blockIdx.x; hg::hgrn_unit(PH, Ya, lbv, hg_norm_g, lds, u >> 3, u & 7, tidp); }
    else { pg8::Gemm g{Hn, WinT + (size_t)NHC * DM, DM, DM, DM}; pg8::SchedPlain S; S.per = 0; S.rep = 1; S.o.init(TH, NRC, G - BPP * 8, (int)blockIdx.x - BPP * 8);
      pg8::EpiBf16 E{PR, NRC}; pg8::gemm_phase(lds, g, S, E, wave); }
    GRID_BAR();
    { const int lane = lane_id_v();
      bf16_t* Pp = PR; bf16_t* Kp = KPE; const float* ct = cosT; const float* st = sinT;
      for (int m0 = gw * 4; m0 < TH; m0 += NGW * 4) {
        u32x4 vq[4], vk[4]; unsigned short k1[4], k2[4]; float cc[4], sn[4];
#pragma unroll
        for (int r = 0; r < 4; ++r) { const bf16_t* pr = Pp + (size_t)(m0 + r) * NRC; const int pos = (m0 + r) & (SEQ - 1);
            vq[r] = (u32x4){0u, 0u, 0u, 0u}; vk[r] = (u32x4){0u, 0u, 0u, 0u}; k1[r] = 0; k2[r] = 0; cc[r] = 0.f; sn[r] = 0.f;
            if (lane < 48) vq[r] = *(const u32x4*)(pr + R_CQ + lane * 8);
            if (lane < 32) { vk[r] = *(const u32x4*)(pr + R_CKV + lane * 8); k1[r] = pr[R_KR + lane]; k2[r] = pr[R_KR + 32 + lane]; cc[r] = ct[pos * 32 + lane]; sn[r] = st[pos * 32 + lane]; } }
#pragma unroll
        for (int r = 0; r < 4; ++r) { bf16_t* pr = Pp + (size_t)(m0 + r) * NRC;
          { const u32x4 v = vq[r]; float f[8] = {bflo(v.x), bfhi(v.x), bflo(v.y), bfhi(v.y), bflo(v.z), bfhi(v.z), bflo(v.w), bfhi(v.w)}; float sq = 0.f;
#pragma unroll
            for (int e = 0; e < 8; ++e) sq += f[e] * f[e];
            const float rn = rsqrtf(wave_sum(sq) * (1.f / QLORA) + EPS);
            if (lane < 48) { u32x4 o; o.x = pk2(f[0] * rn, f[1] * rn); o.y = pk2(f[2] * rn, f[3] * rn); o.z = pk2(f[4] * rn, f[5] * rn); o.w = pk2(f[6] * rn, f[7] * rn); *(u32x4*)(pr + R_CQ + lane * 8) = o; } }
          { const u32x4 v = vk[r]; float f[8] = {bflo(v.x), bfhi(v.x), bflo(v.y), bfhi(v.y), bflo(v.z), bfhi(v.z), bflo(v.w), bfhi(v.w)}; float sq = 0.f;
#pragma unroll
            for (int e = 0; e < 8; ++e) sq += f[e] * f[e];
            const float rn = rsqrtf(wave_sum(sq) * (1.f / KVLORA) + EPS);
            if (lane < 32) { u32x4 o; o.x = pk2(f[0] * rn, f[1] * rn); o.y = pk2(f[2] * rn, f[3] * rn); o.z = pk2(f[4] * rn, f[5] * rn); o.w = pk2(f[6] * rn, f[7] * rn); *(u32x4*)(pr + R_CKV + lane * 8) = o; } }
          if (lane < 32) { const float x1 = bf2f(k1[r]), x2 = bf2f(k2[r]);
            Kp[(size_t)(m0 + r) * 64 + lane] = (bf16_t)f2bf(x1 * cc[r] - x2 * sn[r]); Kp[(size_t)(m0 + r) * 64 + 32 + lane] = (bf16_t)f2bf(x2 * cc[r] + x1 * sn[r]); } }
      } }
    GRID_BAR();
    { pg8::Gemm g{PR + R_CQ, WuqT, NRC, QLORA, QLORA}; pg8::SchedPlain S; S.per = 0; S.rep = 1; S.o.init(TH, NQ, G, (int)blockIdx.x);
      pg8::EpiQRope E{Qb, cosT, sinT}; pg8::gemm_phase(lds, g, S, E, wave); }
    { pg8::Gemm g{PR + R_CKV, WukvT, NRC, KVLORA, KVLORA}; pg8::SchedPlain S; S.per = 0; S.rep = 1; S.o.init(TH, NKV, G, (int)blockIdx.x);
      pg8::EpiBf16 E{KVb, NKV}; pg8::gemm_phase(lds, g, S, E, wave); }
    GRID_BAR();
    { const int tidp = TIDV;
      unsigned* ctrs = (unsigned*)(WSL_ + WS_CTR); const unsigned xcd = xb_xcc_id() & (att::NQUE - 1);
      const att::Bases B{Qb, KVb, KPE, PR, Ybb};
      if (tidp == 0) ((volatile LAS unsigned*)(lds + att::OFF_QW))[1] = 0u;
      int u = att::fetch_unit(ctrs, (LAS char*)lds, tidp, xcd);
      if (u >= 0) {
          att::BlockRef cur = att::make_ref(u); att::Seam S;
          att::attn_prime(B, cur, (LAS char*)lds, S, tidp);
          for (;;) { const int un = att::fetch_unit(ctrs, (LAS char*)lds, tidp, xcd); const bool last = un < 0;
              const att::BlockRef nxt = last ? cur : att::make_ref(un);
              att::attn_block(B, cur, nxt, (LAS char*)lds, S, tidp);
              if (last) break; cur = nxt; }
      } }
    GRID_BAR();
    { pg8::Gemm g{Ya, WpT, DM, DM, DM}; pg8::SchedAB S; S.per = 0; S.rep = 1; S.o.init(TH, DM, G, (int)blockIdx.x);
      pg8::EpiGate E{PR, b_gate, T1, MG}; pg8::gemm_phase(lds, g, S, E, wave); }
    GRID_BAR();
    for (int pm = (int)blockIdx.x; pm < TH / 256; pm += G) {
      { pg8::Gemm g{MG, WoutT, DM, DM, DM}; pg8::SchedRow S{pm};
        pg8::EpiResid E{x_in, OUT_}; pg8::gemm_phase(lds, g, S, E, wave); }
      asm volatile("s_waitcnt vmcnt(0)" ::: "memory"); __syncthreads();
      { const int lane = lane_id_v();
        float* op = OUT_ + (size_t)pm * 256 * DM; const f32x4* gp = (const f32x4*)final_g; f32x4 gg[4];
#pragma unroll
        for (int j = 0; j < 4; ++j) gg[j] = gp[lane + 64 * j];
        for (int m0 = wave * 4; m0 < 256; m0 += 32) {
          f32x4 v[4][4];
#pragma unroll
          for (int r = 0; r < 4; ++r)
#pragma unroll
              for (int j = 0; j < 4; ++j) v[r][j] = ((const f32x4*)(op + (size_t)(m0 + r) * DM))[lane + 64 * j];
#pragma unroll
          for (int r = 0; r < 4; ++r) { float sq = 0.f;
#pragma unroll
              for (int j = 0; j < 4; ++j) sq += (v[r][j].x * v[r][j].x + v[r][j].y * v[r][j].y) + (v[r][j].z * v[r][j].z + v[r][j].w * v[r][j].w);
              const float rn = rsqrtf(wave_sum(sq) * (1.f / DM) + EPS);
#pragma unroll
              for (int j = 0; j < 4; ++j) ((f32x4*)(op + (size_t)(m0 + r) * DM))[lane + 64 * j] = v[r][j] * rn * gg[j]; }
        } }
      __syncthreads();
    }
}

extern "C" void kernel_launch(void* const* d_in, const int* in_sizes, int n_in, void* d_out, int out_size, void* d_ws, size_t ws_size, hipStream_t stream) {
    static int grid = 0;
    if (grid == 0) {
        if (n_in != 14 || in_sizes[0] != TTOK * DM || out_size != TTOK * DM || ws_size < WS_END) { fprintf(stderr, "kernel_launch: shape/workspace mismatch (n_in %d, ws %zu, need %zu)\n", n_in, ws_size, (size_t)WS_END); grid = -1; return; }
        int dev = 0, cus = 0, per_cu = 0;
        if (hipGetDevice(&dev) != hipSuccess || hipDeviceGetAttribute(&cus, hipDeviceAttributeMultiprocessorCount, dev) != hipSuccess) { grid = -1; return; }
        if (hipFuncSetAttribute((const void*)mega_fwd, hipFuncAttributeMaxDynamicSharedMemorySize, LDS_BYTES) != hipSuccess) { fprintf(stderr, "kernel_launch: hipFuncSetAttribute failed\n"); grid = -1; return; }
        if (hipOccupancyMaxActiveBlocksPerMultiprocessor(&per_cu, (const void*)mega_fwd, 512, LDS_BYTES) != hipSuccess || per_cu < 1) { fprintf(stderr, "kernel_launch: occupancy query says %d\n", per_cu); per_cu = 1; }
        (void)hipGetLastError();
        grid = cus;
    }
    if (grid < 0) return;
    Args a{};
    for (int i = 0; i < 14; ++i) a.in[i] = (const float*)d_in[i];
    a.out = (float*)d_out; a.ws = (unsigned char*)d_ws;
    for (int i = 0; i < 32; ++i) a.inv[i] = powf(10000.0f, -(float)(2 * i) / 64.0f);
    void* args[] = {&a};
    hipError_t e = hipLaunchCooperativeKernel((const void*)mega_fwd, dim3(grid), dim3(512), args, LDS_BYTES, stream);
    if (e != hipSuccess) fprintf(stderr, "cooperative launch failed: %s (grid %d)\n", hipGetErrorString(e), grid);
}
```

```cpp
#include <hip/hip_runtime.h>
#include <hip/hip_cooperative_groups.h>
#include <cstdio>
#include <cstdint>
#include <cmath>
namespace cg = cooperative_groups;
#ifndef REP1
#define REP1 1
#endif
#ifndef REP3
#define REP3 1
#endif
#ifndef REPS
#define REPS 1
#endif
#ifndef REPG
#define REPG 1
#endif
#ifndef REP0
#define REP0 1
#endif
#ifndef REP7
#define REP7 1
#endif
#ifndef REPQ
#define REPQ 1
#endif

#define LAS __attribute__((address_space(3)))
typedef unsigned short bf16_t;
typedef short bf16x8 __attribute__((ext_vector_type(8)));
typedef float f32x4 __attribute__((ext_vector_type(4)));
typedef unsigned u32x4 __attribute__((ext_vector_type(4)));
typedef unsigned u32x2 __attribute__((ext_vector_type(2)));

constexpr int DM = 1024, BATCH = 8, SEQ = 8192, TTOK = BATCH * SEQ;
constexpr int TH = TTOK, BPP = BATCH;
constexpr int NIN = 7872, NINP = 7936;
constexpr int NHC = 4096, NRC = 3840;
constexpr int R_CQ = 0, R_CKV = 384, R_KR = 640, R_MZ = 704, R_GL = 1728;
constexpr int C_HQ = 0, C_HF = 1024, C_HI = 2048, C_HZ = 3072, C_CQ = 4096, C_CKV = 4480, C_KR = 4736, C_MZ = 4800, C_GL = 5824;
constexpr int QLORA = 384, KVLORA = 256, NQ = 1536, NKV = 2048;
constexpr float EPS = 1e-6f;
constexpr float ATT_SCALE = 0.07216878364870322f;

constexpr size_t al256(size_t x) { return (x + 255) & ~(size_t)255; }
constexpr size_t WS_WIN = 0;
constexpr size_t WS_WUQ = WS_WIN + (size_t)NINP * DM * 2;
constexpr size_t WS_WUKV = WS_WUQ + (size_t)NQ * QLORA * 2;
constexpr size_t WS_WP = WS_WUKV + (size_t)NKV * KVLORA * 2;
constexpr size_t WS_WOUT = WS_WP + (size_t)2048 * 1024 * 2;
constexpr size_t WS_COS = WS_WOUT + (size_t)1024 * 1024 * 2;
constexpr size_t WS_SIN = WS_COS + (size_t)SEQ * 32 * 4;
constexpr size_t WS_LB = WS_SIN + (size_t)SEQ * 32 * 4;
constexpr size_t WS_CTR = WS_LB + 4096;
constexpr size_t WS_BAR = al256(WS_CTR + 256);
constexpr size_t WS_PH = al256(WS_BAR + 16384);
constexpr size_t WS_PR = WS_PH + (size_t)TTOK * NHC * 2;
constexpr size_t WS_END = WS_PR + (size_t)TTOK * NRC * 2;
constexpr size_t WS_Q = WS_PH;
constexpr size_t WS_KV = WS_Q + (size_t)TTOK * NQ * 2;
constexpr size_t WS_KPE = WS_KV + (size_t)TTOK * NKV * 2;
constexpr size_t WS_T1 = WS_PH;
constexpr size_t WS_MG = WS_T1 + (size_t)TTOK * 1024 * 2;
static_assert(WS_END <= (size_t)1073741824, "workspace map must fit 1 GiB");
static_assert(WS_KPE + (size_t)TTOK * 64 * 2 <= WS_PR && WS_MG + (size_t)TTOK * 1024 * 2 <= WS_PR, "overlays fit inside PH");
constexpr size_t OUT_H_OFF = (size_t)TTOK * DM * 2;
constexpr int YB_OFF_EL = TTOK * DM;

constexpr int LDS_BYTES = 147456;

__device__ __forceinline__ unsigned f2bf(float f) { unsigned u = __builtin_bit_cast(unsigned, f); return (u + 0x7fffu + ((u >> 16) & 1u)) >> 16; }
__device__ __forceinline__ unsigned pk2(float lo, float hi) { return f2bf(lo) | (f2bf(hi) << 16); }
typedef float f32x2_t __attribute__((ext_vector_type(2))); typedef __bf16 bf16x2_t __attribute__((ext_vector_type(2)));
__device__ __forceinline__ unsigned cvtpk_s(float lo, float hi) { f32x2_t v = {lo, hi}; bf16x2_t b = __builtin_convertvector(v, bf16x2_t); return __builtin_bit_cast(unsigned, b); }
__device__ __forceinline__ float bf2f(unsigned short b) { return __builtin_bit_cast(float, (unsigned)b << 16); }
__device__ __forceinline__ float bflo(unsigned w) { return __builtin_bit_cast(float, w << 16); }
__device__ __forceinline__ float bfhi(unsigned w) { return __builtin_bit_cast(float, w & 0xffff0000u); }
__device__ __forceinline__ float sigmoidf_(float x) { return __builtin_amdgcn_rcpf(1.f + __expf(-x)); }
__device__ __forceinline__ float siluf_(float x) { return x * __builtin_amdgcn_rcpf(1.f + __expf(-x)); }
__device__ __forceinline__ float wave_sum(float v) {
#pragma unroll
    for (int o = 1; o < 64; o <<= 1) v += __shfl_xor(v, o);
    return v;
}
__device__ __forceinline__ float wave_max(float v) {
#pragma unroll
    for (int o = 1; o < 64; o <<= 1) v = fmaxf(v, __shfl_xor(v, o));
    return v;
}
#define LDS_WAIT() asm volatile("s_waitcnt lgkmcnt(0)" ::: "memory")
#define LAUNDER(v) asm volatile("" : "+v"(v))
__device__ __forceinline__ int lane_id_v() { int l; asm volatile("v_mbcnt_lo_u32_b32 %0, -1, 0\n\tv_mbcnt_hi_u32_b32 %0, -1, %0" : "=v"(l)); return l; }
__device__ __forceinline__ int wave_id_s() { int w = (int)threadIdx.x >> 6; return __builtin_amdgcn_readfirstlane(w); }

namespace pg8 {
constexpr int BM = 256, BK = 64, HALF = 128, HTB = HALF * BK * 2, STAGE_BYTES = 8 * HTB, NXCD = 8, WGM = 8;
__host__ __device__ __forceinline__ int lds_byte(int r, int c) { const int st = (r >> 4) * 2 + (c >> 5), rr = r & 15, cc = c & 31, ob = rr * 64 + cc * 2; return st * 1024 + (ob ^ (((ob >> 9) & 1) << 5)); }
__host__ __device__ __forceinline__ void stage_rc(int b, int& R, int& C) { const int st = b / 1024, sb = b % 1024, swz = sb ^ (((sb >> 9) & 1) << 5); R = (st >> 1) * 16 + swz / 64; C = (st & 1) * 32 + (swz % 64) / 2; }
__host__ __device__ __forceinline__ int perm32(int rho) { const int n = rho >> 4, i = rho & 15; return 8 * (i >> 2) + 4 * n + (i & 3); }

struct Unit { int pm, pn, acol; };
struct Gemm { const bf16_t* A; const bf16_t* Bt; int lda, ldb, K; };

struct TileOrder {
    int nM, nN, nwg, G, c;
    __device__ void init(int M, int N, int G_, int c_) { nM = M / BM; nN = N / BM; nwg = nM * nN; G = G_; c = c_; }
    __device__ bool tile(int i, int& pm, int& pn) const {
        const long L = (long)i * G + c; if (L >= nwg) return false;
        int wgid = (int)L; { const int q = nwg / NXCD, r = nwg % NXCD, xcd = wgid % NXCD, off = wgid / NXCD; wgid = (xcd < r ? xcd * (q + 1) : r * (q + 1) + (xcd - r) * q) + off; }
        const int nig = WGM * nN, gid = wgid / nig, fm = gid * WGM, gsz = (nM - fm) < WGM ? (nM - fm) : WGM;
        pm = fm + ((wgid % nig) % gsz); pn = (wgid % nig) / gsz; return true;
    }
};
struct SchedPlain { TileOrder o; int per, rep; __device__ bool next(int i, Unit& u) const { int pm, pn; if (rep > 1) { if (i >= per * rep) return false; i = i % per; } if (!o.tile(i, pm, pn)) return false; u.pm = pm; u.pn = pn; u.acol = 0; return true; } };
struct SchedRow { int pm; __device__ bool next(int i, Unit& u) const { if (i >= 4) return false; u.pm = pm; u.pn = i; u.acol = 0; return true; } };
struct SchedAB { TileOrder o; int per, rep; __device__ bool next(int i, Unit& u) const { int pm, pn; if (rep > 1) { if (i >= per * rep) return false; i = i % per; } if (!o.tile(i >> 1, pm, pn)) return false; const int w = i & 1; u.pm = pm; u.pn = pn + 4 * w; u.acol = YB_OFF_EL * w; return true; } };

__device__ __forceinline__ unsigned cvt_pk_bf16(float lo, float hi) { unsigned r; asm volatile("v_cvt_pk_bf16_f32 %0, %1, %2" : "=v"(r) : "v"(lo), "v"(hi)); return r; }

struct EpiBf16 {
    static constexpr bool PERM = true;
    bf16_t* O; int ldc;
    __device__ __forceinline__ void operator()(const f32x4 (&acc)[2][2][4][2], const Unit& u, int wr, int wc, int fr, int fq) const {
        const int row0 = u.pm * BM + wr * 64 + fr; const int col0 = u.pn * BM + wc * 32 + 8 * fq;
#pragma unroll
        for (int ai = 0; ai < 2; ++ai)
#pragma unroll
            for (int m = 0; m < 4; ++m) { bf16_t* rowp = O + (size_t)(row0 + ai * HALF + m * 16) * ldc + col0;
#pragma unroll
                for (int bj = 0; bj < 2; ++bj) { const f32x4 v0 = acc[ai][bj][m][0], v1 = acc[ai][bj][m][1];
                    u32x4 w; w.x = cvt_pk_bf16(v0[0], v0[1]); w.y = cvt_pk_bf16(v0[2], v0[3]); w.z = cvt_pk_bf16(v1[0], v1[1]); w.w = cvt_pk_bf16(v1[2], v1[3]);
                    *(u32x4*)(rowp + bj * HALF) = w; } }
    }
};

struct EpiQRope {
    static constexpr bool PERM = true;
    bf16_t* O; const float* cosT; const float* sinT;
    __device__ __forceinline__ void operator()(const f32x4 (&acc)[2][2][4][2], const Unit& u, int wr, int wc, int fr, int fq) const {
        const int row0 = u.pm * BM + wr * 64 + fr; const int col0 = u.pn * BM + wc * 32 + 8 * fq; const bool rope = u.pn >= 4;
#pragma unroll
        for (int ai = 0; ai < 2; ++ai)
#pragma unroll
            for (int m = 0; m < 4; ++m) { const int row = row0 + ai * HALF + m * 16; bf16_t* rowp = O + (size_t)row * NQ + col0;
                f32x4 a0 = acc[ai][0][m][0], a1 = acc[ai][0][m][1], b0 = acc[ai][1][m][0], b1 = acc[ai][1][m][1];
                if (rope) { const int pos = row & (SEQ - 1); const f32x4 c0 = *(const f32x4*)(cosT + pos * 32 + 8 * fq), c1 = *(const f32x4*)(cosT + pos * 32 + 8 * fq + 4);
                    const f32x4 s0 = *(const f32x4*)(sinT + pos * 32 + 8 * fq), s1 = *(const f32x4*)(sinT + pos * 32 + 8 * fq + 4);
                    const f32x4 x0 = a0 * c0 - b0 * s0, x1 = a1 * c1 - b1 * s1, y0 = b0 * c0 + a0 * s0, y1 = b1 * c1 + a1 * s1; a0 = x0; a1 = x1; b0 = y0; b1 = y1; }
                u32x4 w; w.x = cvt_pk_bf16(a0[0], a0[1]); w.y = cvt_pk_bf16(a0[2], a0[3]); w.z = cvt_pk_bf16(a1[0], a1[1]); w.w = cvt_pk_bf16(a1[2], a1[3]); *(u32x4*)rowp = w;
                w.x = cvt_pk_bf16(b0[0], b0[1]); w.y = cvt_pk_bf16(b0[2], b0[3]); w.z = cvt_pk_bf16(b1[0], b1[1]); w.w = cvt_pk_bf16(b1[2], b1[3]); *(u32x4*)(rowp + HALF) = w; }
    }
};
struct EpiGate {
    static constexpr bool PERM = true;
    const bf16_t* P; const float* bgate; bf16_t* T1; bf16_t* MG;
    __device__ __forceinline__ void operator()(const f32x4 (&acc)[2][2][4][2], const Unit& u, int wr, int wc, int fr, int fq) const {
        const int which = u.pn >> 2; const int row0 = u.pm * BM + wr * 64 + fr; const int col0 = (u.pn & 3) * BM + wc * 32 + 8 * fq;
#pragma unroll
        for (int bj = 0; bj < 2; ++bj) { const int col = col0 + bj * HALF;
            const f32x4 b0 = *(const f32x4*)(bgate + which * 1024 + col), b1 = *(const f32x4*)(bgate + which * 1024 + col + 4);
#pragma unroll
            for (int ai = 0; ai < 2; ++ai)
#pragma unroll
                for (int m = 0; m < 4; ++m) { const size_t row = (size_t)(row0 + ai * HALF + m * 16);
                    const u32x4 gl = *(const u32x4*)(P + row * NRC + R_GL + which * 1024 + col);
                    const f32x4 v0 = acc[ai][bj][m][0], v1 = acc[ai][bj][m][1];
                    float r[8];
                    r[0] = sigmoidf_(bflo(gl.x) + b0[0]) * v0[0]; r[1] = sigmoidf_(bfhi(gl.x) + b0[1]) * v0[1];
                    r[2] = sigmoidf_(bflo(gl.y) + b0[2]) * v0[2]; r[3] = sigmoidf_(bfhi(gl.y) + b0[3]) * v0[3];
                    r[4] = sigmoidf_(bflo(gl.z) + b1[0]) * v1[0]; r[5] = sigmoidf_(bfhi(gl.z) + b1[1]) * v1[1];
                    r[6] = sigmoidf_(bflo(gl.w) + b1[2]) * v1[2]; r[7] = sigmoidf_(bfhi(gl.w) + b1[3]) * v1[3];
                    if (which == 0) { u32x4 w; w.x = cvt_pk_bf16(r[0], r[1]); w.y = cvt_pk_bf16(r[2], r[3]); w.z = cvt_pk_bf16(r[4], r[5]); w.w = cvt_pk_bf16(r[6], r[7]);
                        *(u32x4*)(T1 + row * 1024 + col) = w; }
                    else { const u32x4 t = *(const u32x4*)(T1 + row * 1024 + col);
                        u32x4 w; w.x = cvt_pk_bf16(r[0] + bflo(t.x), r[1] + bfhi(t.x)); w.y = cvt_pk_bf16(r[2] + bflo(t.y), r[3] + bfhi(t.y));
                        w.z = cvt_pk_bf16(r[4] + bflo(t.z), r[5] + bfhi(t.z)); w.w = cvt_pk_bf16(r[6] + bflo(t.w), r[7] + bfhi(t.w));
                        *(u32x4*)(MG + row * 1024 + col) = w; } } }
    }
};
struct EpiResid {
    static constexpr bool PERM = false;
    const float* X; float* O;
    __device__ __forceinline__ void operator()(const f32x4 (&acc)[2][2][4][2], const Unit& u, int wr, int wc, int fr, int fq) const {
        const int row0 = u.pm * BM + wr * 64 + fr; const int col0 = u.pn * BM + wc * 32 + 4 * fq;
#pragma unroll
        for (int ai = 0; ai < 2; ++ai)
#pragma unroll
            for (int m = 0; m < 4; ++m) { const size_t off = (size_t)(row0 + ai * HALF + m * 16) * 1024 + col0;
#pragma unroll
                for (int bj = 0; bj < 2; ++bj)
#pragma unroll
                    for (int n = 0; n < 2; ++n) { const f32x4 xv = *(const f32x4*)(X + off + bj * HALF + n * 16); *(f32x4*)(O + off + bj * HALF + n * 16) = xv + acc[ai][bj][m][n]; } }
    }
};

template <class Epi, class Sched>
__device__ __forceinline__ void gemm_phase(LAS unsigned char* lds, const Gemm g, const Sched& S, const Epi& E, const int wave_s) {
    const int wid = wave_s;
    const int tid = wid * 64 + lane_id_v(), lane = tid & 63, wr = wid >> 2, wc = wid & 3, fr = lane & 15, fq = lane >> 4;
    const int K = g.K, nt = K / BK;
    unsigned voffA[2], voffB[2];
#pragma unroll
    for (int i = 0; i < 2; ++i) { int R, C; stage_rc(tid * 16 + i * 8192, R, C); const int Rb = Epi::PERM ? ((R & ~31) + perm32(R & 31)) : R;
        voffA[i] = (unsigned)(R * g.lda + C) * 2u; voffB[i] = (unsigned)(Rb * g.ldb + C) * 2u; }
    const size_t kstep = (size_t)(BK * 2);
    const size_t hstepA = (size_t)HALF * g.lda * 2, hstepB = (size_t)HALF * g.ldb * 2;
    const size_t tstepA = 2 * hstepA, tstepB = 2 * hstepB;
    const unsigned ldsw = (unsigned)wid * 1024u;
    const int aoff = lds_byte(wr * 64 + fr, fq * 8), boff = lds_byte(wc * 32 + fr, fq * 8);
#define PG8_SA(b, h) (((b) * 2 + (h)) * HTB)
#define PG8_SB(b, h) ((4 + (b) * 2 + (h)) * HTB)
#define PG8_STAGE(bufoff, gbase, voff) do { _Pragma("unroll") for (int _i = 0; _i < 2; ++_i) \
        __builtin_amdgcn_global_load_lds((const unsigned*)((const char*)(gbase) + (voff)[_i]), (LAS unsigned*)(lds + (bufoff) + ldsw + _i * 8192), 16, 0, 0); } while (0)
#define PG8_LDA(dst, b, h) do { _Pragma("unroll") for (int m = 0; m < 4; ++m) _Pragma("unroll") for (int k = 0; k < 2; ++k) dst[m][k] = *(const LAS bf16x8*)(lds + PG8_SA(b, h) + aoff + m * 2048 + k * 1024); } while (0)
#define PG8_LDB(dst, b, h) do { _Pragma("unroll") for (int n = 0; n < 2; ++n) _Pragma("unroll") for (int k = 0; k < 2; ++k) dst[n][k] = *(const LAS bf16x8*)(lds + PG8_SB(b, h) + boff + n * 2048 + k * 1024); } while (0)
#define PG8_MMA(ai, bj, At, Bt) do { __builtin_amdgcn_s_setprio(1); _Pragma("unroll") for (int m = 0; m < 4; ++m) _Pragma("unroll") for (int n = 0; n < 2; ++n) _Pragma("unroll") for (int k = 0; k < 2; ++k) \
        acc[ai][bj][m][n] = __builtin_amdgcn_mfma_f32_16x16x32_bf16(Bt[n][k], At[m][k], acc[ai][bj][m][n], 0, 0, 0); __builtin_amdgcn_s_setprio(0); } while (0)
#define PG8_WAIT_V(n) asm volatile("s_waitcnt vmcnt(" #n ")" ::: "memory")
#define PG8_WAIT_L(n) asm volatile("s_waitcnt lgkmcnt(" #n ")" ::: "memory")
#define PG8_BAR __builtin_amdgcn_s_barrier()
#define PG8_SCHED __builtin_amdgcn_sched_barrier(0)
    Unit cur, nxt; int ui = 0;
    if (!S.next(0, cur)) return;
    f32x4 acc[2][2][4][2];
#pragma unroll
    for (int a = 0; a < 2; ++a)
#pragma unroll
        for (int b = 0; b < 2; ++b)
#pragma unroll
            for (int m = 0; m < 4; ++m)
#pragma unroll
                for (int n = 0; n < 2; ++n) acc[a][b][m][n] = (f32x4){0.f, 0.f, 0.f, 0.f};
    bf16x8 At[4][2], B0[2][2], B1[2][2];
    const char* cA = (const char*)g.A + (size_t)cur.pm * tstepA + (size_t)cur.acol * 2; const char* cB = (const char*)g.Bt + (size_t)cur.pn * tstepB;
    PG8_STAGE(PG8_SB(0, 0), cB, voffB); PG8_STAGE(PG8_SB(0, 1), cB + hstepB, voffB); PG8_STAGE(PG8_SA(0, 0), cA, voffA); PG8_STAGE(PG8_SA(0, 1), cA + hstepA, voffA);
    if (wr == 1) PG8_BAR;
    PG8_WAIT_V(2); PG8_BAR;
    PG8_STAGE(PG8_SB(1, 0), cB + kstep, voffB); PG8_STAGE(PG8_SA(1, 0), cA + kstep, voffA); PG8_STAGE(PG8_SB(1, 1), cB + hstepB + kstep, voffB);
    PG8_WAIT_V(6); PG8_BAR;
    for (;;) {
        const bool has_next = S.next(ui + 1, nxt);
        const char* nA = has_next ? (const char*)g.A + (size_t)nxt.pm * tstepA + (size_t)nxt.acol * 2 : cA; const char* nB = has_next ? (const char*)g.Bt + (size_t)nxt.pn * tstepB : cB;
#pragma unroll 1
        for (int t = 0; t < nt; t += 2) {
            const bool last = (t == nt - 2);
            const char* a1 = cA + (size_t)(t + 1) * kstep;
            const char* a2 = last ? nA : cA + (size_t)(t + 2) * kstep; const char* b2 = last ? nB : cB + (size_t)(t + 2) * kstep;
            const char* a3 = a2 + kstep; const char* b3 = b2 + kstep;
            PG8_LDB(B0, 0, 0); PG8_LDB(B1, 0, 1); PG8_SCHED; PG8_LDA(At, 0, 0); PG8_STAGE(PG8_SA(1, 1), a1 + hstepA, voffA);
            PG8_WAIT_V(8); PG8_WAIT_L(0); PG8_BAR; PG8_MMA(0, 0, At, B0); PG8_MMA(0, 1, At, B1); PG8_BAR; PG8_SCHED;
            PG8_LDA(At, 0, 1); PG8_STAGE(PG8_SB(0, 0), b2, voffB); PG8_STAGE(PG8_SB(0, 1), b2 + hstepB, voffB); PG8_STAGE(PG8_SA(0, 0), a2, voffA);
            PG8_WAIT_V(8); PG8_WAIT_L(0); PG8_BAR; PG8_MMA(1, 0, At, B0); PG8_MMA(1, 1, At, B1); PG8_BAR; PG8_SCHED;
            PG8_LDB(B0, 1, 0); PG8_LDB(B1, 1, 1); PG8_SCHED; PG8_LDA(At, 1, 0); PG8_STAGE(PG8_SA(0, 1), a2 + hstepA, voffA);
            PG8_WAIT_V(8); PG8_WAIT_L(0); PG8_BAR; PG8_MMA(0, 0, At, B0); PG8_MMA(0, 1, At, B1); PG8_BAR; PG8_SCHED;
            PG8_LDA(At, 1, 1); PG8_STAGE(PG8_SB(1, 0), b3, voffB); PG8_STAGE(PG8_SB(1, 1), b3 + hstepB, voffB); PG8_STAGE(PG8_SA(1, 0), a3, voffA);
            PG8_WAIT_V(8); PG8_WAIT_L(0); PG8_BAR; PG8_MMA(1, 0, At, B0); PG8_MMA(1, 1, At, B1); PG8_BAR; PG8_SCHED;
        }
        if (wr == 0) PG8_BAR;
        E(acc, cur, wr, wc, fr, fq);
        if (!has_next) break;
#pragma unroll
        for (int a = 0; a < 2; ++a)
#pragma unroll
            for (int b = 0; b < 2; ++b)
#pragma unroll
                for (int m = 0; m < 4; ++m)
#pragma unroll
                    for (int n = 0; n < 2; ++n) acc[a][b][m][n] = (f32x4){0.f, 0.f, 0.f, 0.f};
        cur = nxt; cA = nA; cB = nB; ++ui;
        if (wr == 1) PG8_BAR;
    }
    PG8_WAIT_V(0);
    PG8_BAR;
#undef PG8_SA
#undef PG8_SB
#undef PG8_STAGE
#undef PG8_LDA
#undef PG8_LDB
#undef PG8_MMA
#undef PG8_WAIT_V
#undef PG8_WAIT_L
#undef PG8_BAR
#undef PG8_SCHED
}
}

__device__ __forceinline__ int qmap(int n) { const int h = n / 192, d = n % 192; if (d < 128) return h * 128 + d; const int i = d - 128; return 1024 + (h >> 2) * 256 + (i >> 5) * 128 + (h & 3) * 32 + (i & 31); }
template <bool QMAP = false>
__device__ __forceinline__ void transpose_item(const float* W, int K, int N, bf16_t* WT, int row_off, const float* gain, LAS float* scr, int item, int lane) {
    const int nblk = N / 32, kb = item / nblk, nb = item % nblk, k0 = 64 * kb, n0 = 32 * nb; const int d0 = QMAP ? qmap(n0) : n0;
#pragma unroll 8
    for (int i = 0; i < 32; ++i) { const int kk = 2 * i + (lane >> 5); const float gk = gain ? gain[k0 + kk] : 1.f; scr[kk * 33 + (lane & 31)] = W[(size_t)(k0 + kk) * N + n0 + (lane & 31)] * gk; }
    LDS_WAIT(); asm volatile("" ::: "memory");
    const int c = lane & 7;
#pragma unroll
    for (int j = 0; j < 4; ++j) { const int n = (lane >> 3) + 8 * j; const LAS float* s = scr + (8 * c) * 33 + n;
        u32x4 o; o.x = pk2(s[0 * 33], s[1 * 33]); o.y = pk2(s[2 * 33], s[3 * 33]); o.z = pk2(s[4 * 33], s[5 * 33]); o.w = pk2(s[6 * 33], s[7 * 33]);
        *(u32x4*)(WT + (size_t)(row_off + d0 + n) * K + k0 + 8 * c) = o; }
    LDS_WAIT(); asm volatile("" ::: "memory");
}

struct Args { const float* in[14]; float* out; unsigned char* ws; float inv[32]; };

namespace att {
typedef short s16x4 __attribute__((ext_vector_type(4)));
typedef float f32x16 __attribute__((ext_vector_type(16)));
constexpr int NW = 8, QBLK = 32, KVBLK = 64, QB = 256;
constexpr int SHM_V = 16384, SHM_K = 17408, SHM_R = 9216;
constexpr int OFF_V = 0, OFF_K = 3 * SHM_V,     OFF_R = OFF_K + 2 * SHM_K, OFF_WS = OFF_R + 2 * SHM_R, OFF_QR = OFF_WS + NW * 64 * 4, ATT_LDS = OFF_QR + NW * 4096;
constexpr float THR = 8.f;
#define KSWZ(row, colB) ((row) * 272 + (colB))
#define RSWZ(row, colB) ((row) * 144 + (colB))
#define SBAR() __builtin_amdgcn_sched_barrier(0)
__device__ __forceinline__ int v_st(int k, int c) { const int kk = (k & ~0xC) | ((k & 4) << 1) | ((k & 8) >> 1); return ((kk >> 3) * 4 + (c >> 5)) * 512 + ((kk & 7) * 32 + (c & 31)) * 2; }
__device__ __forceinline__ int v_rd_base(int lane) { return ((lane & 3) << 3) | (((lane >> 2) & 3) << 6) | (((lane >> 4) & 1) << 5) | (((lane >> 5) & 1) << 8); }
constexpr int v_rd_off(int d0, int ks, int half) { return d0 * 512 + ks * 4096 + half * 2048; }
__device__ __forceinline__ int crow(int r, int hi) { return (r & 3) + 8 * (r >> 2) + 4 * hi; }
__device__ __forceinline__ unsigned cvtpk(float lo, float hi) { unsigned r; asm volatile("v_cvt_pk_bf16_f32 %0, %1, %2" : "=v"(r) : "v"(lo), "v"(hi)); return r; }
__device__ __forceinline__ bf16x8 load8(const bf16_t* p) { return *reinterpret_cast<const bf16x8*>(p); }
__device__ __forceinline__ void mask_tile(f32x16& p0, f32x16& p1, int dq) {
    const float NEG = -__builtin_inff();
#pragma unroll
    for (int r = 0; r < 16; ++r) { const int c = (r & 3) + 8 * (r >> 2); if (dq - c < 0) p0[r] = NEG; if (dq - c - 32 < 0) p1[r] = NEG; }
}
__device__ __forceinline__ void partialSM(f32x16& p0, f32x16& p1, float& m_reg, float& mn, float& alpha) {
    float pmax = p0[0];
#pragma unroll
    for (int r = 1; r < 16; ++r) pmax = fmaxf(pmax, p0[r]);
#pragma unroll
    for (int r = 0; r < 16; ++r) pmax = fmaxf(pmax, p1[r]);
    { auto rr = __builtin_amdgcn_permlane32_swap(__float_as_uint(pmax), __float_as_uint(pmax), false, false);
      pmax = fmaxf(__uint_as_float(rr[0]), __uint_as_float(rr[1])); }
    constexpr float C2 = 1.4426950408889634f * ATT_SCALE;
    if (__builtin_expect(__all((pmax - m_reg) * ATT_SCALE <= THR), 1)) { mn = m_reg; alpha = 1.f; }
    else { mn = fmaxf(m_reg, pmax); alpha = __builtin_amdgcn_exp2f((m_reg - mn) * C2); m_reg = mn; }
    const float mnL = -mn * C2;
#pragma unroll
    for (int r = 0; r < 16; ++r) p0[r] = fmaf(p0[r], C2, mnL);
#pragma unroll
    for (int r = 0; r < 16; ++r) p1[r] = fmaf(p1[r], C2, mnL);
#pragma unroll
    for (int r = 0; r < 16; ++r) p0[r] = __builtin_amdgcn_exp2f(p0[r]);
}
__device__ __forceinline__ void finishSM(f32x16& p0, f32x16& p1, float alpha, float& l_reg, bf16x8& pa0, bf16x8& pa1, bf16x8& pa2, bf16x8& pa3) {
#pragma unroll
    for (int r = 0; r < 16; ++r) p1[r] = __builtin_amdgcn_exp2f(p1[r]);
    float ps = 0;
#pragma unroll
    for (int r = 0; r < 16; ++r) ps += p0[r];
#pragma unroll
    for (int r = 0; r < 16; ++r) ps += p1[r];
    { auto rr = __builtin_amdgcn_permlane32_swap(__float_as_uint(ps), __float_as_uint(ps), false, false);
      ps = __uint_as_float(rr[0]) + __uint_as_float(rr[1]); }
    l_reg = l_reg * alpha + ps;
#define PK4(P, B_, OUT) do { unsigned a0 = cvtpk(P[B_+0], P[B_+1]), a1 = cvtpk(P[B_+2], P[B_+3]);                          \
        unsigned b0 = cvtpk(P[B_+4], P[B_+5]), b1 = cvtpk(P[B_+6], P[B_+7]);                                             \
        auto r0 = __builtin_amdgcn_permlane32_swap(a0, b0, false, false); auto r1 = __builtin_amdgcn_permlane32_swap(a1, b1, false, false); \
        u32x4 w = {r0[0], r1[0], r0[1], r1[1]}; OUT = *reinterpret_cast<bf16x8*>(&w); } while (0)
    PK4(p0, 0, pa0); PK4(p0, 8, pa1); PK4(p1, 0, pa2); PK4(p1, 8, pa3);
#undef PK4
}
template <int KB>
__device__ __forceinline__ void qkt(f32x16& p0, f32x16& p1, const LAS char* lds, int r32, int hi, const bf16x8* qr, const LAS char* qrb) {
    p0 = f32x16{}; p1 = f32x16{};
    { const LAS char* kbp = lds + OFF_K + KB * SHM_K + KSWZ(r32, hi * 16);
#pragma unroll
    for (int d0 = 0; d0 < 8; ++d0) { const LAS char* a = kbp + d0 * 32;
        const bf16x8 b0 = *reinterpret_cast<const LAS bf16x8*>(a);
        const bf16x8 b1 = *reinterpret_cast<const LAS bf16x8*>(a + 32 * 272);
        p0 = __builtin_amdgcn_mfma_f32_32x32x16_bf16(b0, qr[d0], p0, 0, 0, 0);
        p1 = __builtin_amdgcn_mfma_f32_32x32x16_bf16(b1, qr[d0], p1, 0, 0, 0); } }
    { const LAS char* rb = lds + OFF_R + KB * SHM_R + RSWZ(r32, hi * 16);
#pragma unroll
    for (int d0 = 0; d0 < 4; ++d0) { const LAS char* a = rb + d0 * 32;
        const bf16x8 b0 = *reinterpret_cast<const LAS bf16x8*>(a);
        const bf16x8 b1 = *reinterpret_cast<const LAS bf16x8*>(a + 32 * 144);
        const bf16x8 qv = *reinterpret_cast<const LAS bf16x8*>(qrb + d0 * 1024);
        p0 = __builtin_amdgcn_mfma_f32_32x32x16_bf16(b0, qv, p0, 0, 0, 0);
        p1 = __builtin_amdgcn_mfma_f32_32x32x16_bf16(b1, qv, p1, 0, 0, 0); } }
}
template <int VB>
__device__ __forceinline__ void pv_tile(f32x16* o, int vb0, bf16x8 pa0, bf16x8 pa1, bf16x8 pa2, bf16x8 pa3) {
#define TRRD(dst, off) asm volatile("ds_read_b64_tr_b16 %0, %1 offset:%2" : "=&v"(dst) : "v"(vb0), "i"(off) : "memory")
#define PV_D0(d0) do { s16x4 l0, l1, l2, l3, h0, h1, h2, h3; constexpr int b_ = OFF_V + VB * SHM_V + v_rd_off(d0, 0, 0); \
        TRRD(l0, b_); TRRD(h0, b_ + 2048); TRRD(l1, b_ + 4096); TRRD(h1, b_ + 6144); TRRD(l2, b_ + 8192); TRRD(h2, b_ + 10240); TRRD(l3, b_ + 12288); TRRD(h3, b_ + 14336); \
        asm volatile("s_waitcnt lgkmcnt(0)" ::: "memory"); SBAR();   \
        o[d0] = __builtin_amdgcn_mfma_f32_32x32x16_bf16(pa0, (bf16x8){l0[0], l0[1], l0[2], l0[3], h0[0], h0[1], h0[2], h0[3]}, o[d0], 0, 0, 0);   \
        o[d0] = __builtin_amdgcn_mfma_f32_32x32x16_bf16(pa1, (bf16x8){l1[0], l1[1], l1[2], l1[3], h1[0], h1[1], h1[2], h1[3]}, o[d0], 0, 0, 0);   \
        o[d0] = __builtin_amdgcn_mfma_f32_32x32x16_bf16(pa2, (bf16x8){l2[0], l2[1], l2[2], l2[3], h2[0], h2[1], h2[2], h2[3]}, o[d0], 0, 0, 0);   \
        o[d0] = __builtin_amdgcn_mfma_f32_32x32x16_bf16(pa3, (bf16x8){l3[0], l3[1], l3[2], l3[3], h3[0], h3[1], h3[2], h3[3]}, o[d0], 0, 0, 0); } while (0)
    PV_D0(0); PV_D0(1); PV_D0(2); PV_D0(3);
#undef PV_D0
#undef TRRD
}
struct BlockRef { int bl, h, qb; };
struct Bases { const bf16_t* Q; const bf16_t* KV; const bf16_t* KPE; const bf16_t* P; bf16_t* Y; };
#define R_K(r) (B.KV + (size_t)(r).bl * SEQ * NKV + (r).h * 256)
#define R_V(r) (B.KV + (size_t)(r).bl * SEQ * NKV + (r).h * 256 + 128)
#define R_R(r) (B.KPE + (size_t)(r).bl * SEQ * 64)
#define R_QN(r) (B.Q + ((size_t)(r).bl * SEQ + (size_t)(r).qb * QB) * NQ + (r).h * 128)
#define R_QR(r) (B.Q + ((size_t)(r).bl * SEQ + (size_t)(r).qb * QB) * NQ + 1024 + ((r).h >> 2) * 256 + ((r).h & 3) * 32)
#define R_Z(r) (B.P + ((size_t)(r).bl * SEQ + (size_t)(r).qb * QB) * NRC + R_MZ + (r).h * 128)
#define R_O(r) (B.Y + ((size_t)(r).bl * SEQ + (size_t)(r).qb * QB) * 1024 + (r).h * 128)
struct Seam { bf16x8 qr[8]; bf16x8 st_v0, st_v1, st_k0, st_k1, st_r; };
#define VMW() asm volatile("s_waitcnt vmcnt(0)" ::: "memory")
#define VMWN(n) asm volatile("s_waitcnt vmcnt(%0)" :: "i"(n) : "memory")
#define LDU8(ubase, off) (*(const bf16x8*)((const char*)(ubase) + (off)))
#define SLOAD_H(Kp, Vp, Rp, k0) do { int t_ = tid; LAUNDER(t_); const unsigned kvoff_ = (unsigned)((t_ >> 4) * NKV + (t_ & 15) * 8) * 2u, roff_ = (unsigned)((t_ >> 3) * 64 + (t_ & 7) * 8) * 2u; \
                         S.st_v0 = LDU8((Vp) + (size_t)(k0) * NKV, kvoff_); S.st_v1 = LDU8((Vp) + (size_t)((k0) + 32) * NKV, kvoff_); \
                         S.st_k0 = LDU8((Kp) + (size_t)(k0) * NKV, kvoff_); S.st_k1 = LDU8((Kp) + (size_t)((k0) + 32) * NKV, kvoff_); \
                         S.st_r = LDU8((Rp) + (size_t)(k0) * 64, roff_); } while (0)
#define SWRITE_HK(bf) do { int t_ = tid; LAUNDER(t_); const int kws_ = KSWZ(t_ >> 4, (t_ & 15) * 16), rws_ = RSWZ(t_ >> 3, (t_ & 7) * 16); \
                           *(LAS bf16x8*)(lds + OFF_K + (bf) * SHM_K + kws_) = S.st_k0; *(LAS bf16x8*)(lds + OFF_K + (bf) * SHM_K + kws_ + 32 * 272) = S.st_k1; \
                           *(LAS bf16x8*)(lds + OFF_R + (bf) * SHM_R + rws_) = S.st_r; } while (0)
#define SWRITE_HV(bf) do { int t_ = tid; LAUNDER(t_); const int vst0_ = v_st(t_ >> 4, (t_ & 15) * 8), vst1_ = v_st(32 + (t_ >> 4), (t_ & 15) * 8); \
                           *(LAS bf16x8*)(lds + OFF_V + (bf) * SHM_V + vst0_) = S.st_v0; *(LAS bf16x8*)(lds + OFF_V + (bf) * SHM_V + vst1_) = S.st_v1; } while (0)
#define SWRITE_H(bf) do { SWRITE_HV(bf); SWRITE_HK(bf); } while (0)
#define QOFF_ ({ int t_ = tid; LAUNDER(t_); (unsigned)((t_ & 31) * NQ + ((t_ >> 5) & 1) * 8) * 2u; })
#define QLOAD(B_) do { const bf16_t* qn_ = R_QN(B_) + (size_t)(wid * QBLK) * NQ; const unsigned qoff_ = QOFF_; \
        _Pragma("unroll") for (int d0 = 0; d0 < 8; ++d0) S.qr[d0] = LDU8(qn_ + d0 * 16, qoff_); } while (0)
#define QLOAD_R(B_) const bf16_t* qr_ = R_QR(B_) + (size_t)(wid * QBLK) * NQ; const unsigned qoffr_ = QOFF_; \
        const bf16x8 qt0 = LDU8(qr_, qoffr_), qt1 = LDU8(qr_ + 16, qoffr_), qt2 = LDU8(qr_ + 128, qoffr_), qt3 = LDU8(qr_ + 144, qoffr_)
#define QWRITE_R() do { *(LAS bf16x8*)(qrb) = qt0; *(LAS bf16x8*)(qrb + 1024) = qt1; *(LAS bf16x8*)(qrb + 2048) = qt2; *(LAS bf16x8*)(qrb + 3072) = qt3; } while (0)
__device__ __forceinline__ void attn_prime(const Bases& B, const BlockRef& cur, LAS char* lds, Seam& S, int tid) {
    const int wid = __builtin_amdgcn_readfirstlane(tid >> 6), lane = tid & 63, r32 = lane & 31, hi = lane >> 5;
    LAS char* qrb = lds + OFF_QR + wid * 4096 + lane * 16;
    QLOAD(cur); QLOAD_R(cur);
    SLOAD_H(R_K(cur), R_V(cur), R_R(cur), 0); VMW(); SWRITE_HK(0); QWRITE_R();
    __syncthreads();
}
__device__ __forceinline__ void attn_block(const Bases& B, const BlockRef& cur, const BlockRef& nxt, LAS char* lds, Seam& S, int tid) {
    const int wid = __builtin_amdgcn_readfirstlane(tid >> 6), lane = tid & 63, r32 = lane & 31, hi = lane >> 5;
    const int P0 = cur.qb * QB, NT = (P0 + QB - 1) / KVBLK + 1;
    const int qlo = P0 + wid * QBLK, qm = qlo + r32 - 4 * hi;
    LAS float* ws = (LAS float*)(lds + OFF_WS) + wid * 64; LAS float* li_l = ws; LAS float* al_l = ws + 32;
    float m_reg = -1e30f, l_reg = 0; f32x16 o[4] = {};
    const int vb0 = (int)(unsigned)(uintptr_t)lds + v_rd_base(lane);
    LAS char* qrb = lds + OFF_QR + wid * 4096 + lane * 16;
#define Kh R_K(cur)
#define Vh R_V(cur)
#define Rh R_R(cur)
#define RESC(a) do { if (__any((a) < 1.f)) { if (hi == 0) al_l[r32] = (a); asm volatile("s_waitcnt lgkmcnt(0)" ::: "memory");              \
                     for (int d_ = 0; d_ < 4; ++d_) for (int r = 0; r < 16; ++r) o[d_][r] *= al_l[crow(r, hi)]; } } while (0)
#define KBASE(t) ((t) * KVBLK)
#define MASKT(P0_, P1_, t) do { const int kb_ = KBASE(t); if (kb_ + KVBLK - 1 > qlo) mask_tile(P0_, P1_, qm - kb_); } while (0)
    f32x16 pA0, pA1, pB0, pB1; float mnA, mnB, alA, alB; bf16x8 pa0, pa1, pa2, pa3;
    SWRITE_HV(0); SBAR();
    if (NT > 1) { SLOAD_H(Kh, Vh, Rh, KBASE(1)); }
    SBAR(); qkt<0>(pA0, pA1, lds, r32, hi, S.qr, qrb);
    MASKT(pA0, pA1, 0); partialSM(pA0, pA1, m_reg, mnA, alA);
    if (NT > 1) { VMW(); SWRITE_H(1); }
    __syncthreads();
    int vr = 0;
#define HALF_STEP(PX0, PX1, mnX, alX, PY0, PY1, alY, t, KB, SB) do {                                                          \
        SBAR(); qkt<KB>(PX0, PX1, lds, r32, hi, S.qr, qrb);                                                                   \
        finishSM(PY0, PY1, alY, l_reg, pa0, pa1, pa2, pa3); SBAR();                                                           \
        if ((t) + 1 < NT) { SLOAD_H(Kh, Vh, Rh, KBASE((t) + 1)); SBAR(); }                                                    \
        pv_tile<0>(o, vb0 + vr * SHM_V, pa0, pa1, pa2, pa3); MASKT(PX0, PX1, (t)); partialSM(PX0, PX1, m_reg, mnX, alX);      \
        { const int vw = vr == 0 ? 2 : vr - 1;                                                                                \
          if ((t) + 1 < NT) { VMW(); SWRITE_HK(SB); SWRITE_HV(vw); } }                                                        \
        RESC(alX); __syncthreads(); vr = vr == 2 ? 0 : vr + 1; } while (0)
    for (int t = 1; t + 1 < NT; t += 2) {
        HALF_STEP(pB0, pB1, mnB, alB, pA0, pA1, alA, t, 1, 0);
        HALF_STEP(pA0, pA1, mnA, alA, pB0, pB1, alB, t + 1, 0, 1);
    }
    const bool even = (NT & 1) == 0;
    if (even) { SBAR(); qkt<1>(pB0, pB1, lds, r32, hi, S.qr, qrb); SBAR(); }
    SLOAD_H(R_K(nxt), R_V(nxt), R_R(nxt), 0); SBAR();
    QLOAD(nxt);
    SBAR();
    finishSM(pA0, pA1, alA, l_reg, pa0, pa1, pa2, pa3); SBAR();
    pv_tile<0>(o, vb0 + vr * SHM_V, pa0, pa1, pa2, pa3);
    if (even) { MASKT(pB0, pB1, NT - 1); partialSM(pB0, pB1, m_reg, mnB, alB); __syncthreads(); RESC(alB);
        finishSM(pB0, pB1, alB, l_reg, pa0, pa1, pa2, pa3); SBAR(); pv_tile<0>(o, vb0 + (vr == 2 ? 0 : vr + 1) * SHM_V, pa0, pa1, pa2, pa3); }
    SBAR(); VMWN(8); SWRITE_HK(0); SBAR();
    QLOAD_R(nxt);
    if (hi == 0) li_l[r32] = l_reg; asm volatile("s_waitcnt lgkmcnt(0)" ::: "memory");
    bf16_t* Ow = R_O(cur) + (size_t)(wid * QBLK) * 1024; const bf16_t* Zw = R_Z(cur) + (size_t)(wid * QBLK) * NRC;
    int l_ = tid; LAUNDER(l_); const int hi_ = (l_ >> 5) & 1, r32_ = l_ & 31;
    const unsigned zoff = (unsigned)(4 * hi_ * NRC + r32_) * 2u, ooff = (unsigned)(4 * hi_ * 1024 + r32_) * 2u;
    unsigned short zr[16][4];
#pragma unroll
    for (int r = 0; r < 16; ++r) { const int rc = (r & 3) + 8 * (r >> 2);
#pragma unroll
        for (int d0 = 0; d0 < 4; ++d0) zr[r][d0] = *(const bf16_t*)((const char*)(Zw + (size_t)rc * NRC + d0 * 32) + zoff); }
#pragma unroll
    for (int r = 0; r < 16; ++r) { const int rc = (r & 3) + 8 * (r >> 2); const float rli = __builtin_amdgcn_rcpf(li_l[rc + 4 * hi]);
#pragma unroll
        for (int d0 = 0; d0 < 4; ++d0) { const float z = bf2f(zr[r][d0]); const float v = o[d0][r] * rli * siluf_(z);
            const float vn = __builtin_bit_cast(float, __builtin_amdgcn_mov_dpp(__builtin_bit_cast(int, v), 0xB1, 0xF, 0xF, true));
            if ((r32 & 1) == 0) *(unsigned*)((char*)(Ow + (size_t)rc * 1024 + d0 * 32) + ooff) = cvtpk(v, vn); } }
    QWRITE_R();
    __syncthreads();
#undef Kh
#undef Vh
#undef Rh
#undef RESC
#undef KBASE
#undef MASKT
#undef HALF_STEP
}
constexpr int NQUE = 8, BHQ = BPP * 8 / NQUE, QPER = BHQ * 32, OFF_QW = ATT_LDS;
__device__ __forceinline__ int unit_bh(int code) { const int q = code / QPER, v = code % QPER; return q * BHQ + v % BHQ; }
__device__ __forceinline__ BlockRef make_ref(int code) { BlockRef r; const int bh = unit_bh(code), a = code % QPER; r.bl = bh >> 3; r.h = bh & 7; r.qb = 31 - a / BHQ; return r; }
__device__ __forceinline__ int fetch_unit(unsigned* ctrs, LAS char* lds, int tid, unsigned x) {
    if (tid == 0) { volatile LAS unsigned* w = (volatile LAS unsigned*)(lds + OFF_QW); unsigned k = w[1]; int code = -1;
        while (k < (unsigned)NQUE) { const unsigned q = (x + k) & (NQUE - 1); const unsigned v = __hip_atomic_fetch_add(ctrs + q, 1u, __ATOMIC_RELAXED, __HIP_MEMORY_SCOPE_AGENT);
            if (v < (unsigned)QPER) { code = (int)(q * QPER + v); break; } ++k; }
        w[1] = k; w[0] = (unsigned)code; }
    __syncthreads();
    const int u = (int)*(volatile LAS unsigned*)(lds + OFF_QW);
    return __builtin_amdgcn_readfirstlane(u);
}
#undef KSWZ
#undef RSWZ
#undef SLOAD_H
#undef SWRITE_HK
#undef SWRITE_HV
#undef SWRITE_H
#undef QLOAD
#undef QLOAD_R
#undef QWRITE_R
#undef VMW
#undef VMWN
}


namespace hg {
constexpr int QI_S = 272, KT_S = 144, A_S = 144, ST_S = 272;
constexpr int OFF_QI = 0, OFF_KI = OFF_QI + 64 * QI_S, OFF_KOT = OFF_KI + 64 * QI_S, OFF_VT = OFF_KOT + 128 * KT_S, OFF_A = OFF_VT + 128 * KT_S,
              OFF_ST = OFF_A + 64 * A_S, OFF_SEG = OFF_ST + 128 * ST_S, OFF_DEC = OFF_SEG + 2048, OFF_SSQ = OFF_DEC + 512, HG_LDS = OFF_SSQ + 512;
#define MFMA16(a, b, c) __builtin_amdgcn_mfma_f32_16x16x32_bf16(a, b, c, 0, 0, 0)
__device__ __forceinline__ void hgrn_unit(const bf16_t* P, bf16_t* Y, const float* lb, const float* hgn, LAS unsigned char* lds, int bl, int h, int tid) {
    const int lane = tid & 63, w = __builtin_amdgcn_readfirstlane(tid >> 6), fr = lane & 15, fq = lane >> 4;
    const int k = tid & 127, seg = tid >> 7, tt = w & 3, vh = w >> 2;
    const float lbk = lb[h * 128 + k];
    for (int i = tid; i < 128 * ST_S / 16; i += 512) *(LAS u32x4*)(lds + OFF_ST + i * 16) = (u32x4){0u, 0u, 0u, 0u};
    f32x4 S[8];
#pragma unroll
    for (int i = 0; i < 8; ++i) S[i] = (f32x4){0.f, 0.f, 0.f, 0.f};
    const bf16_t* Pb = P + (size_t)bl * SEQ * NHC + h * 128;
    unsigned short rq[16], rf[16], ri[16];
    { const bf16_t* p = Pb + (size_t)(seg * 16) * NHC + k;
#pragma unroll
      for (int j = 0; j < 16; ++j) { rq[j] = p[(size_t)j * NHC + C_HQ]; rf[j] = p[(size_t)j * NHC + C_HF]; ri[j] = p[(size_t)j * NHC + C_HI]; } }
    LAS float* segs = (LAS float*)(lds + OFF_SEG); LAS float* decs = (LAS float*)(lds + OFF_DEC); LAS float* ssq = (LAS float*)(lds + OFF_SSQ);
    const float oml = 1.f - lbk; constexpr float L2E = 1.4426950408889634f;
    float c[16], om[16]; f32x4 o[4]; u32x2 rz[4];
#define HG_A1() do { float run = 0.f; _Pragma("unroll") for (int j = 0; j < 16; ++j) { const float sg = __builtin_amdgcn_rcpf(1.f + __builtin_amdgcn_exp2f(-L2E * bf2f(rf[j]))); \
            const float f = fmaf(oml, sg, lbk); om[j] = fmaf(-oml, sg, oml); run += __builtin_amdgcn_logf(f); c[j] = run; } segs[seg * 128 + k] = run; } while (0)
#define HG_OUT(t0_) do { const float tot = ssq[tt * 16 + fr] + ssq[64 + tt * 16 + fr]; const float rn = rsqrtf(tot * (1.f / 128.f) + EPS); \
          bf16_t* yp = Y + ((size_t)bl * SEQ + (t0_) + tt * 16 + fr) * 1024 + h * 128; \
          _Pragma("unroll") for (int i = 0; i < 4; ++i) { const int v0 = (vh * 4 + i) * 16 + 4 * fq; const f32x4 g4 = *(const f32x4*)(hgn + v0); \
              const float y0 = o[i][0] * rn * g4[0] * siluf_(bflo(rz[i].x)), y1 = o[i][1] * rn * g4[1] * siluf_(bfhi(rz[i].x)); \
              const float y2 = o[i][2] * rn * g4[2] * siluf_(bflo(rz[i].y)), y3 = o[i][3] * rn * g4[3] * siluf_(bfhi(rz[i].y)); \
              *(u32x2*)(yp + v0) = (u32x2){cvtpk_s(y0, y1), cvtpk_s(y2, y3)}; } } while (0)
    HG_A1();
#pragma unroll 1
    for (int n = 0; n < SEQ / 64; ++n) {
        const int t0 = n * 64;
        __syncthreads();
        if (n > 0) HG_OUT(t0 - 64);
#pragma unroll
        for (int i = 0; i < 4; ++i) rz[i] = *(const u32x2*)(Pb + (size_t)(t0 + tt * 16 + fr) * NHC + C_HZ + (vh * 4 + i) * 16 + 4 * fq);
        { const float s0 = segs[k], s1 = segs[128 + k], s2 = segs[256 + k], s3 = segs[384 + k];
          const float offs = (seg > 0 ? s0 : 0.f) + (seg > 1 ? s1 : 0.f) + (seg > 2 ? s2 : 0.f), total = (s0 + s1) + (s2 + s3);
          unsigned ko[8], vv[8];
          const float dk = __builtin_amdgcn_exp2f(total);
#pragma unroll
          for (int j = 0; j < 16; j += 2) {
              const float e0 = __builtin_amdgcn_exp2f(offs + c[j]), e1 = __builtin_amdgcn_exp2f(offs + c[j + 1]);
              const float r0 = __builtin_amdgcn_rcpf(e0), r1 = __builtin_amdgcn_rcpf(e1);
              const float hq0 = bf2f(rq[j]), hq1 = bf2f(rq[j + 1]);
              const float q0 = hq0 * e0 * __builtin_amdgcn_rcpf(1.f + __builtin_amdgcn_exp2f(-L2E * hq0)), q1 = hq1 * e1 * __builtin_amdgcn_rcpf(1.f + __builtin_amdgcn_exp2f(-L2E * hq1));
              const unsigned qw = cvtpk_s(q0, q1);
              const float ki0 = om[j] * r0, ki1 = om[j + 1] * r1;
              const unsigned kw = cvtpk_s(ki0, ki1);
              const int t = seg * 16 + j;
              *(LAS bf16_t*)(lds + OFF_QI + t * QI_S + k * 2) = (bf16_t)(qw & 0xffffu); *(LAS bf16_t*)(lds + OFF_QI + (t + 1) * QI_S + k * 2) = (bf16_t)(qw >> 16);
              *(LAS bf16_t*)(lds + OFF_KI + t * QI_S + k * 2) = (bf16_t)(kw & 0xffffu); *(LAS bf16_t*)(lds + OFF_KI + (t + 1) * QI_S + k * 2) = (bf16_t)(kw >> 16);
              ko[j >> 1] = cvtpk_s(ki0 * dk, ki1 * dk);
              vv[j >> 1] = (unsigned)ri[j] | ((unsigned)ri[j + 1] << 16);
          }
          *(LAS u32x4*)(lds + OFF_KOT + k * KT_S + seg * 32) = (u32x4){ko[0], ko[1], ko[2], ko[3]}; *(LAS u32x4*)(lds + OFF_KOT + k * KT_S + seg * 32 + 16) = (u32x4){ko[4], ko[5], ko[6], ko[7]};
          *(LAS u32x4*)(lds + OFF_VT + k * KT_S + seg * 32) = (u32x4){vv[0], vv[1], vv[2], vv[3]}; *(LAS u32x4*)(lds + OFF_VT + k * KT_S + seg * 32 + 16) = (u32x4){vv[4], vv[5], vv[6], vv[7]};
          if (seg == 0) decs[k] = dk;
        }
        { const int tn = (n + 1 < SEQ / 64 ? t0 + 64 : t0) + seg * 16; const bf16_t* p = Pb + (size_t)tn * NHC + k;
#pragma unroll
          for (int j = 0; j < 16; ++j) { rq[j] = p[(size_t)j * NHC + C_HQ]; rf[j] = p[(size_t)j * NHC + C_HF]; ri[j] = p[(size_t)j * NHC + C_HI]; } }
        __syncthreads();
        bf16x8 qf[4];
#pragma unroll
        for (int ks = 0; ks < 4; ++ks) qf[ks] = *(const LAS bf16x8*)(lds + OFF_QI + (tt * 16 + fr) * QI_S + (ks * 32 + 8 * fq) * 2);
#pragma unroll
        for (int si = 0; si < 2; ++si) { const int st = 2 * vh + si; f32x4 acc = (f32x4){0.f, 0.f, 0.f, 0.f};
            if (st <= tt) {
#pragma unroll
                for (int ks = 0; ks < 4; ++ks) { const bf16x8 kf = *(const LAS bf16x8*)(lds + OFF_KI + (st * 16 + fr) * QI_S + (ks * 32 + 8 * fq) * 2); acc = MFMA16(kf, qf[ks], acc); } }
            const int tg = tt * 16 + fr, sg = st * 16 + 4 * fq;
#pragma unroll
            for (int r = 0; r < 4; ++r) if (sg + r > tg) acc[r] = 0.f;
            *(LAS u32x2*)(lds + OFF_A + tg * A_S + sg * 2) = (u32x2){cvtpk_s(acc[0], acc[1]), cvtpk_s(acc[2], acc[3])}; }
#pragma unroll
        for (int i = 0; i < 4; ++i) { o[i] = (f32x4){0.f, 0.f, 0.f, 0.f}; const int vt = vh * 4 + i;
#pragma unroll
            for (int ks = 0; ks < 4; ++ks) { const bf16x8 sf = *(const LAS bf16x8*)(lds + OFF_ST + (vt * 16 + fr) * ST_S + (ks * 32 + 8 * fq) * 2); o[i] = MFMA16(sf, qf[ks], o[i]); } }
        __syncthreads();
        { bf16x8 af[2];
#pragma unroll
          for (int ks = 0; ks < 2; ++ks) af[ks] = *(const LAS bf16x8*)(lds + OFF_A + (tt * 16 + fr) * A_S + (ks * 32 + 8 * fq) * 2);
#pragma unroll
          for (int i = 0; i < 4; ++i) { const int vt = vh * 4 + i;
#pragma unroll
              for (int ks = 0; ks < 2; ++ks) { const bf16x8 vf = *(const LAS bf16x8*)(lds + OFF_VT + (vt * 16 + fr) * KT_S + (ks * 32 + 8 * fq) * 2); o[i] = MFMA16(vf, af[ks], o[i]); } } }
        { const f32x4 dec4 = *(const LAS f32x4*)(lds + OFF_DEC + (w * 16 + 4 * fq) * 4);
          bf16x8 kof[2];
#pragma unroll
          for (int ks = 0; ks < 2; ++ks) kof[ks] = *(const LAS bf16x8*)(lds + OFF_KOT + (w * 16 + fr) * KT_S + (ks * 32 + 8 * fq) * 2);
#pragma unroll
          for (int vt = 0; vt < 8; ++vt) { S[vt] = S[vt] * dec4;
#pragma unroll
              for (int ks = 0; ks < 2; ++ks) { const bf16x8 vf = *(const LAS bf16x8*)(lds + OFF_VT + (vt * 16 + fr) * KT_S + (ks * 32 + 8 * fq) * 2); S[vt] = MFMA16(kof[ks], vf, S[vt]); }
              *(LAS u32x2*)(lds + OFF_ST + (vt * 16 + fr) * ST_S + (w * 16 + 4 * fq) * 2) = (u32x2){cvtpk_s(S[vt][0], S[vt][1]), cvtpk_s(S[vt][2], S[vt][3])}; } }
        { float ss = 0.f;
#pragma unroll
          for (int i = 0; i < 4; ++i) ss += (o[i][0] * o[i][0] + o[i][1] * o[i][1]) + (o[i][2] * o[i][2] + o[i][3] * o[i][3]);
          ss += __shfl_xor(ss, 16); ss += __shfl_xor(ss, 32);
          if (fq == 0) ssq[vh * 64 + tt * 16 + fr] = ss; }
        HG_A1();
    }
    __syncthreads();
    HG_OUT(SEQ - 64);
    __syncthreads();
#undef HG_A1
#undef HG_OUT
}
#undef MFMA16
}

#define XB_TMO      128
#define XB_XCNT(j)  (256  + 64 * (j))
#define XB_XSUB(j)  (1280 + 64 * (j))
#define XB_XGEN(j)  (2304 + 64 * (j))
#define XB_TOP      3328
#define XB_TOPGEN   3392
#define XCD_BAR_WORDS 3456
#define XB_SPIN_CAP (1u << 20)
__device__ __forceinline__ unsigned xb_ld(unsigned* p)              { return __hip_atomic_load(p, __ATOMIC_RELAXED, __HIP_MEMORY_SCOPE_AGENT); }
__device__ __forceinline__ unsigned xb_add(unsigned* p, unsigned v) { return __hip_atomic_fetch_add(p, v, __ATOMIC_RELAXED, __HIP_MEMORY_SCOPE_AGENT); }
__device__ __forceinline__ unsigned xb_xcc_id() { return (unsigned)__builtin_amdgcn_s_getreg((3 << 11) | 20) & 0xFu; }
#define XB_SPIN(cond, bar) do { unsigned _sp = 0; while (cond) { __builtin_amdgcn_s_sleep(1); \
    if ((++_sp & 255u) == 0u) { if (xb_ld(&(bar)[XB_TMO])) break; if (_sp > XB_SPIN_CAP) { atomicAdd(&(bar)[XB_TMO], 1u); break; } } } } while (0)
struct XcdBarrier { unsigned* bar; unsigned x; volatile LAS unsigned* st; };
__device__ __forceinline__ XcdBarrier xcd_barrier_post(unsigned* bar, volatile LAS unsigned* st) {
    XcdBarrier b; b.bar = bar; b.x = xb_xcc_id(); b.st = st;
    if (threadIdx.x == 0) (void)xb_add(&bar[XB_XCNT(b.x)], 1u);
    return b;
}
__device__ __forceinline__ void xcd_barrier_complete(unsigned* bar, unsigned x, unsigned& nloc, unsigned& nx) {
    const unsigned G = gridDim.x * gridDim.y * gridDim.z;
    unsigned sum, cnt, mine, sp = 0u;
    for (;;) {
        sum = 0u; cnt = 0u; mine = 0u;
#pragma unroll
        for (unsigned j = 0; j < 16; ++j) { const unsigned c = xb_ld(&bar[XB_XCNT(j)]); sum += c; cnt += (c > 0u) ? 1u : 0u; mine = (j == x) ? c : mine; }
        if (sum == G) break;
        __builtin_amdgcn_s_sleep(1);
        if ((++sp & 255u) == 0u) { if (xb_ld(&bar[XB_TMO])) break; if (sp > XB_SPIN_CAP) { atomicAdd(&bar[XB_TMO], 1u); break; } }
    }
    nloc = mine > 0u ? mine : 1u; nx = cnt > 0u ? cnt : 1u;
}
__device__ __forceinline__ void xcd_barrier(unsigned* bar, volatile LAS unsigned* st) {
    asm volatile("s_waitcnt vmcnt(0)" ::: "memory");
    __syncthreads();
    if (threadIdx.x == 0) {
        const unsigned x = xb_xcc_id();
        __builtin_amdgcn_s_waitcnt(0);
        unsigned nloc = st[0], nx = st[1];
        if (nloc == 0u) { xcd_barrier_complete(bar, x, nloc, nx); st[0] = nloc; st[1] = nx; }
        const unsigned old = xb_add(&bar[XB_XSUB(x)], 1u);
        const unsigned gen = old / nloc;
        if (old + 1u == (gen + 1u) * nloc) {
            __builtin_amdgcn_fence(__ATOMIC_RELEASE, "agent");
            asm volatile("s_waitcnt vmcnt(0)" ::: "memory");
            const unsigned og = xb_add(&bar[XB_TOP], 1u);
            const unsigned tg = og / nx;
            if (og + 1u == (tg + 1u) * nx) xb_add(&bar[XB_TOPGEN], 1u);
            else XB_SPIN(xb_ld(&bar[XB_TOPGEN]) == tg, bar);
            __builtin_amdgcn_fence(__ATOMIC_ACQUIRE, "agent");
            xb_add(&bar[XB_XGEN(x)], 1u);
            asm volatile("s_waitcnt vmcnt(0)" ::: "memory");
        } else {
            XB_SPIN(xb_ld(&bar[XB_XGEN(x)]) == gen, bar);
            __builtin_amdgcn_fence(__ATOMIC_ACQUIRE, "agent");
            asm volatile("s_waitcnt vmcnt(0)" ::: "memory");
        }
    }
    __syncthreads();
}

__device__ __forceinline__ const void* karg_ptr(int byte_off) {
    const __attribute__((address_space(1))) void* p;
    const unsigned long long kpi = (unsigned long long)__builtin_amdgcn_kernarg_segment_ptr();
    const unsigned lo = __builtin_amdgcn_readfirstlane((unsigned)kpi), hi = __builtin_amdgcn_readfirstlane((unsigned)(kpi >> 32));
    const unsigned long long k2 = ((unsigned long long)hi << 32) | lo;
    asm volatile("s_load_dwordx2 %0, %1, %2\n\ts_waitcnt lgkmcnt(0)" : "=s"(p) : "s"(k2), "n"(byte_off) : "memory"); return (const void*)p;
}
static_assert(offsetof(Args, out) == 112 && offsetof(Args, ws) == 120, "kernarg offsets");
__global__ void __launch_bounds__(512, 2) mega_fwd(Args a) {
    extern __shared__ __attribute__((aligned(16))) unsigned char lds_raw[];
    LAS unsigned char* lds = (LAS unsigned char*)lds_raw;
    cg::grid_group grid = cg::this_grid();
    const int wave = wave_id_s();
#define TIDV (wave * 64 + lane_id_v())
#define BAR_ST ((volatile LAS unsigned*)(lds + LDS_BYTES - 64))
#define BAR_W ((unsigned*)((unsigned char*)karg_ptr(120) + WS_BAR))
#define GRID_BAR() xcd_barrier(BAR_W, BAR_ST)
    if (threadIdx.x == 0) { BAR_ST[0] = 0u; BAR_ST[1] = 0u; }
    if (blockIdx.x == 0) { unsigned* bw = BAR_W; for (int i = (int)threadIdx.x; i < XCD_BAR_WORDS; i += 512) bw[i] = 0u; }
    __syncthreads();
    const int G = gridDim.x, gw = blockIdx.x * 8 + wave, NGW = G * 8;
#define IN_(i) ((const float*)karg_ptr(8 * (i)))
#define x_in IN_(0)
#define norm_g IN_(1)
#define w_in IN_(2)
#define b_gate IN_(3)
#define lb_logits IN_(4)
#define hg_norm_g IN_(5)
#define q_a_g IN_(6)
#define w_uq IN_(7)
#define kv_a_g IN_(8)
#define w_ukv IN_(9)
#define w_pa IN_(10)
#define w_pb IN_(11)
#define w_out IN_(12)
#define final_g IN_(13)
#define OUT_ ((float*)karg_ptr(112))
#define WSL_ ((unsigned char*)karg_ptr(120))
#define WinT ((bf16_t*)(WSL_ + WS_WIN))
#define WuqT ((bf16_t*)(WSL_ + WS_WUQ))
#define WukvT ((bf16_t*)(WSL_ + WS_WUKV))
#define WpT ((bf16_t*)(WSL_ + WS_WP))
#define WoutT ((bf16_t*)(WSL_ + WS_WOUT))
#define cosT ((float*)(WSL_ + WS_COS))
#define sinT ((float*)(WSL_ + WS_SIN))
#define lbv ((float*)(WSL_ + WS_LB))
#define PH ((bf16_t*)(WSL_ + WS_PH))
#define PR ((bf16_t*)(WSL_ + WS_PR))
#define Qb ((bf16_t*)(WSL_ + WS_Q))
#define KVb ((bf16_t*)(WSL_ + WS_KV))
#define KPE ((bf16_t*)(WSL_ + WS_KPE))
#define Ya ((bf16_t*)OUT_)
#define Ybb ((bf16_t*)((unsigned char*)OUT_ + OUT_H_OFF))
#define T1 ((bf16_t*)(WSL_ + WS_T1))
#define MG ((bf16_t*)(WSL_ + WS_MG))
#define Hn ((bf16_t*)((unsigned char*)OUT_ + OUT_H_OFF))

#if !defined(SKIP0)
    for (int rep0_ = 0; rep0_ < REP0; ++rep0_)
    {
        const int lane = lane_id_v(); const int tidp = wave * 64 + lane;
        LAS float* scr = (LAS float*)(lds + wave * 16384);
        constexpr int I_IN = (DM / 64) * (NIN / 32), I_UQ = (QLORA / 64) * (NQ / 32), I_UKV = (KVLORA / 64) * (NKV / 32), I_SQ = (DM / 64) * (DM / 32);
        constexpr int NITEMS = I_IN + I_UQ + I_UKV + 3 * I_SQ;
        for (int it = gw; it < NITEMS; it += NGW) {
            int r = it;
            if (r < I_IN) { transpose_item(w_in, DM, NIN, WinT, 0, nullptr, scr, r, lane); continue; } r -= I_IN;
            if (r < I_UQ) { transpose_item<true>(w_uq, QLORA, NQ, WuqT, 0, q_a_g, scr, r, lane); continue; } r -= I_UQ;
            if (r < I_UKV) { transpose_item(w_ukv, KVLORA, NKV, WukvT, 0, kv_a_g, scr, r, lane); continue; } r -= I_UKV;
            if (r < I_SQ) { transpose_item(w_pa, DM, DM, WpT, 0, nullptr, scr, r, lane); continue; } r -= I_SQ;
            if (r < I_SQ) { transpose_item(w_pb, DM, DM, WpT, 1024, nullptr, scr, r, lane); continue; } r -= I_SQ;
            transpose_item(w_out, DM, DM, WoutT, 0, nullptr, scr, r, lane);
        }
        for (int i = blockIdx.x * 512 + tidp; i < (NINP - NIN) * DM / 8; i += G * 512) *(u32x4*)(WinT + (size_t)NIN * DM + (size_t)i * 8) = (u32x4){0u, 0u, 0u, 0u};
        for (int i = blockIdx.x * 512 + tidp; i < SEQ * 32; i += G * 512) { const int pos = i >> 5, f = i & 31; const float ang = (float)pos * a.inv[f];
            const double r = (double)ang * 0.15915494309189535; const double fr = r - __builtin_rint(r);
            const float rad = (float)(fr * 6.283185307179586);
            cosT[i] = __cosf(rad); sinT[i] = __sinf(rad); }
        if (blockIdx.x == 0 && tidp < 64) ((unsigned*)(WSL_ + WS_CTR))[tidp] = 0u;
        for (int i = blockIdx.x * 512 + tidp; i < 1024; i += G * 512) lbv[i] = sigmoidf_(lb_logits[i] - lb_logits[1024 + i]);
        { const float* xp = x_in; bf16_t* hp = Hn; const f32x4* gp = (const f32x4*)norm_g; f32x4 gg[4];
#pragma unroll
          for (int j = 0; j < 4; ++j) gg[j] = gp[lane + 64 * j];
          for (int m0 = gw * 4; m0 < TTOK; m0 += NGW * 4) {
            f32x4 v[4][4];
#pragma unroll
            for (int r = 0; r < 4; ++r)
#pragma unroll
                for (int j = 0; j < 4; ++j) v[r][j] = ((const f32x4*)(xp + (size_t)(m0 + r) * DM))[lane + 64 * j];
#pragma unroll
            for (int r = 0; r < 4; ++r) { float sq = 0.f;
#pragma unroll
                for (int j = 0; j < 4; ++j) sq += (v[r][j].x * v[r][j].x + v[r][j].y * v[r][j].y) + (v[r][j].z * v[r][j].z + v[r][j].w * v[r][j].w);
                const float rn = rsqrtf(wave_sum(sq) * (1.f / DM) + EPS);
                unsigned long long* o8 = (unsigned long long*)(hp + (size_t)(m0 + r) * DM) + lane;
#pragma unroll
                for (int j = 0; j < 4; ++j) o8[64 * j] = (unsigned long long)pk2(v[r][j].x * rn * gg[j].x, v[r][j].y * rn * gg[j].y) | ((unsigned long long)pk2(v[r][j].z * rn * gg[j].z, v[r][j].w * rn * gg[j].w) << 32); }
          } }
    }
#endif
    grid.sync();
    if (threadIdx.x == 0) (void)xb_add(&BAR_W[XB_XCNT(xb_xcc_id())], 1u);

    { pg8::Gemm g{Hn, WinT, DM, DM, DM}; pg8::SchedPlain S; S.per = 0; S.rep = 1; S.o.init(TH, NHC, G, (int)blockIdx.x);
      pg8::EpiBf16 E{PH, NHC}; pg8::gemm_phase(lds, g, S, E, wave); }
    GRID_BAR();
    if ((int)blockIdx.x < BPP * 8) { const int tidp = TIDV; const int u = (int)blockIdx.x; hg::hgrn_unit(PH, Ya, lbv, hg_norm_g, lds, u >> 3, u & 7, tidp); }
    else { pg8::Gemm g{Hn, WinT + (size_t)NHC * DM, DM, DM, DM}; pg8::SchedPlain S; S.per = 0; S.rep = 1; S.o.init(TH, NRC, G - BPP * 8, (int)blockIdx.x - BPP * 8);
      pg8::EpiBf16 E{PR, NRC}; pg8::gemm_phase(lds, g, S, E, wave); }
    GRID_BAR();
    { const int lane = lane_id_v();
      bf16_t* Pp = PR; bf16_t* Kp = KPE; const float* ct = cosT; const float* st = sinT;
      for (int m0 = gw * 4; m0 < TH; m0 += NGW * 4) {
        u32x4 vq[4], vk[4]; unsigned short k1[4], k2[4]; float cc[4], sn[4];
#pragma unroll
        for (int r = 0; r < 4; ++r) { const bf16_t* pr = Pp + (size_t)(m0 + r) * NRC; const int pos = (m0 + r) & (SEQ - 1);
            vq[r] = (u32x4){0u, 0u, 0u, 0u}; vk[r] = (u32x4){0u, 0u, 0u, 0u}; k1[r] = 0; k2[r] = 0; cc[r] = 0.f; sn[r] = 0.f;
            if (lane < 48) vq[r] = *(const u32x4*)(pr + R_CQ + lane * 8);
            if (lane < 32) { vk[r] = *(const u32x4*)(pr + R_CKV + lane * 8); k1[r] = pr[R_KR + lane]; k2[r] = pr[R_KR + 32 + lane]; cc[r] = ct[pos * 32 + lane]; sn[r] = st[pos * 32 + lane]; } }
#pragma unroll
        for (int r = 0; r < 4; ++r) { bf16_t* pr = Pp + (size_t)(m0 + r) * NRC;
          { const u32x4 v = vq[r]; float f[8] = {bflo(v.x), bfhi(v.x), bflo(v.y), bfhi(v.y), bflo(v.z), bfhi(v.z), bflo(v.w), bfhi(v.w)}; float sq = 0.f;
#pragma unroll
            for (int e = 0; e < 8; ++e) sq += f[e] * f[e];
            const float rn = rsqrtf(wave_sum(sq) * (1.f / QLORA) + EPS);
            if (lane < 48) { u32x4 o; o.x = pk2(f[0] * rn, f[1] * rn); o.y = pk2(f[2] * rn, f[3] * rn); o.z = pk2(f[4] * rn, f[5] * rn); o.w = pk2(f[6] * rn, f[7] * rn); *(u32x4*)(pr + R_CQ + lane * 8) = o; } }
          { const u32x4 v = vk[r]; float f[8] = {bflo(v.x), bfhi(v.x), bflo(v.y), bfhi(v.y), bflo(v.z), bfhi(v.z), bflo(v.w), bfhi(v.w)}; float sq = 0.f;
#pragma unroll
            for (int e = 0; e < 8; ++e) sq += f[e] * f[e];
            const float rn = rsqrtf(wave_sum(sq) * (1.f / KVLORA) + EPS);
            if (lane < 32) { u32x4 o; o.x = pk2(f[0] * rn, f[1] * rn); o.y = pk2(f[2] * rn, f[3] * rn); o.z = pk2(f[4] * rn, f[5] * rn); o.w = pk2(f[6] * rn, f[7] * rn); *(u32x4*)(pr + R_CKV + lane * 8) = o; } }
          if (lane < 32) { const float x1 = bf2f(k1[r]), x2 = bf2f(k2[r]);
            Kp[(size_t)(m0 + r) * 64 + lane] = (bf16_t)f2bf(x1 * cc[r] - x2 * sn[r]); Kp[(size_t)(m0 + r) * 64 + 32 + lane] = (bf16_t)f2bf(x2 * cc[r] + x1 * sn[r]); } }
      } }
    GRID_BAR();
    { pg8::Gemm g{PR + R_CQ, WuqT, NRC, QLORA, QLORA}; pg8::SchedPlain S; S.per = 0; S.rep = 1; S.o.init(TH, NQ, G, (int)blockIdx.x);
      pg8::EpiQRope E{Qb, cosT, sinT}; pg8::gemm_phase(lds, g, S, E, wave); }
    { pg8::Gemm g{PR + R_CKV, WukvT, NRC, KVLORA, KVLORA}; pg8::SchedPlain S; S.per = 0; S.rep = 1; S.o.init(TH, NKV, G, (int)blockIdx.x);
      pg8::EpiBf16 E{KVb, NKV}; pg8::gemm_phase(lds, g, S, E, wave); }
    GRID_BAR();
    { const int tidp = TIDV;
      unsigned* ctrs = (unsigned*)(WSL_ + WS_CTR); const unsigned xcd = xb_xcc_id() & (att::NQUE - 1);
      const att::Bases B{Qb, KVb, KPE, PR, Ybb};
      if (tidp == 0) ((volatile LAS unsigned*)(lds + att::OFF_QW))[1] = 0u;
      int u = att::fetch_unit(ctrs, (LAS char*)lds, tidp, xcd);
      if (u >= 0) {
          att::BlockRef cur = att::make_ref(u); att::Seam S;
          att::attn_prime(B, cur, (LAS char*)lds, S, tidp);
          for (;;) { const int un = att::fetch_unit(ctrs, (LAS char*)lds, tidp, xcd); const bool last = un < 0;
              const att::BlockRef nxt = last ? cur : att::make_ref(un);
              att::attn_block(B, cur, nxt, (LAS char*)lds, S, tidp);
              if (last) break; cur = nxt; }
      } }
    GRID_BAR();
    { pg8::Gemm g{Ya, WpT, DM, DM, DM}; pg8::SchedAB S; S.per = 0; S.rep = 1; S.o.init(TH, DM, G, (int)blockIdx.x);
      pg8::EpiGate E{PR, b_gate, T1, MG}; pg8::gemm_phase(lds, g, S, E, wave); }
    GRID_BAR();
    for (int pm = (int)blockIdx.x; pm < TH / 256; pm += G) {
      { pg8::Gemm g{MG, WoutT, DM, DM, DM}; pg8::SchedRow S{pm};
        pg8::EpiResid E{x_in, OUT_}; pg8::gemm_phase(lds, g, S, E, wave); }
      asm volatile("s_waitcnt vmcnt(0)" ::: "memory"); __syncthreads();
      { const int lane = lane_id_v();
        float* op = OUT_ + (size_t)pm * 256 * DM; const f32x4* gp = (const f32x4*)final_g; f32x4 gg[4];
#pragma unroll
        for (int j = 0; j < 4; ++j) gg[j] = gp[lane + 64 * j];
        for (int m0 = wave * 4; m0 < 256; m0 += 32) {
          f32x4 v[4][4];
#pragma unroll
          for (int r = 0; r < 4; ++r)
#pragma unroll
              for (int j = 0; j < 4; ++j) v[r][j] = ((const f32x4*)(op + (size_t)(m0 + r) * DM))[lane + 64 * j];
#pragma unroll
          for (int r = 0; r < 4; ++r) { float sq = 0.f;
#pragma unroll
              for (int j = 0; j < 4; ++j) sq += (v[r][j].x * v[r][j].x + v[r][j].y * v[r][j].y) + (v[r][j].z * v[r][j].z + v[r][j].w * v[r][j].w);
              const float rn = rsqrtf(wave_sum(sq) * (1.f / DM) + EPS);
#pragma unroll
              for (int j = 0; j < 4; ++j) ((f32x4*)(op + (size_t)(m0 + r) * DM))[lane + 64 * j] = v[r][j] * rn * gg[j]; }
        } }
      __syncthreads();
    }
}

extern "C" void kernel_launch(void* const* d_in, const int* in_sizes, int n_in, void* d_out, int out_size, void* d_ws, size_t ws_size, hipStream_t stream) {
    static int grid = 0;
    if (grid == 0) {
        if (n_in != 14 || in_sizes[0] != TTOK * DM || out_size != TTOK * DM || ws_size < WS_END) { fprintf(stderr, "kernel_launch: shape/workspace mismatch (n_in %d, ws %zu, need %zu)\n", n_in, ws_size, (size_t)WS_END); grid = -1; return; }
        int dev = 0, cus = 0, per_cu = 0;
        if (hipGetDevice(&dev) != hipSuccess || hipDeviceGetAttribute(&cus, hipDeviceAttributeMultiprocessorCount, dev) != hipSuccess) { grid = -1; return; }
        if (hipFuncSetAttribute((const void*)mega_fwd, hipFuncAttributeMaxDynamicSharedMemorySize, LDS_BYTES) != hipSuccess) { fprintf(stderr, "kernel_launch: hipFuncSetAttribute failed\n"); grid = -1; return; }
        if (hipOccupancyMaxActiveBlocksPerMultiprocessor(&per_cu, (const void*)mega_fwd, 512, LDS_BYTES) != hipSuccess || per_cu < 1) { fprintf(stderr, "kernel_launch: occupancy query says %d\n", per_cu); per_cu = 1; }
        (void)hipGetLastError();
        grid = cus;
    }
    if (grid < 0) return;
    Args a{};
    for (int i = 0; i < 14; ++i) a.in[i] = (const float*)d_in[i];
    a.out = (float*)d_out; a.ws = (unsigned char*)d_ws;
    for (int i = 0; i < 32; ++i) a.inv[i] = powf(10000.0f, -(float)(2 * i) / 64.0f);
    void* args[] = {&a};
    hipError_t e = hipLaunchCooperativeKernel((const void*)mega_fwd, dim3(grid), dim3(512), args, LDS_BYTES, stream);
    if (e != hipSuccess) fprintf(stderr, "cooperative launch failed: %s (grid %d)\n", hipGetErrorString(e), grid);
}
```

```cpp
#include <hip/hip_runtime.h>
#include <hip/hip_cooperative_groups.h>
#include <cstdio>
#include <cstdint>
#include <cmath>
namespace cg = cooperative_groups;
#ifndef REP1
#define REP1 1
#endif
#ifndef REP3
#define REP3 1
#endif
#ifndef REPS
#define REPS 1
#endif
#ifndef REPG
#define REPG 1
#endif
#ifndef REP0
#define REP0 1
#endif
#ifndef REP7
#define REP7 1
#endif
#ifndef REPQ
#define REPQ 1
#endif

#define LAS __attribute__((address_space(3)))
typedef unsigned short bf16_t;
typedef short bf16x8 __attribute__((ext_vector_type(8)));
typedef float f32x4 __attribute__((ext_vector_type(4)));
typedef unsigned u32x4 __attribute__((ext_vector_type(4)));
typedef unsigned u32x2 __attribute__((ext_vector_type(2)));

constexpr int DM = 1024, BATCH = 8, SEQ = 8192, TTOK = BATCH * SEQ;
constexpr int TH = TTOK, BPP = BATCH;
constexpr int NIN = 7872, NINP = 7936;
constexpr int NHC = 4096, NRC = 3840;
constexpr int R_CQ = 0, R_CKV = 384, R_KR = 640, R_MZ = 704, R_GL = 1728;
constexpr int C_HQ = 0, C_HF = 1024, C_HI = 2048, C_HZ = 3072, C_CQ = 4096, C_CKV = 4480, C_KR = 4736, C_MZ = 4800, C_GL = 5824;
constexpr int QLORA = 384, KVLORA = 256, NQ = 1536, NKV = 2048;
constexpr float EPS = 1e-6f;
constexpr float ATT_SCALE = 0.07216878364870322f;

constexpr size_t al256(size_t x) { return (x + 255) & ~(size_t)255; }
constexpr size_t WS_WIN = 0;
constexpr size_t WS_WUQ = WS_WIN + (size_t)NINP * DM * 2;
constexpr size_t WS_WUKV = WS_WUQ + (size_t)NQ * QLORA * 2;
constexpr size_t WS_WP = WS_WUKV + (size_t)NKV * KVLORA * 2;
constexpr size_t WS_WOUT = WS_WP + (size_t)2048 * 1024 * 2;
constexpr size_t WS_COS = WS_WOUT + (size_t)1024 * 1024 * 2;
constexpr size_t WS_SIN = WS_COS + (size_t)SEQ * 32 * 4;
constexpr size_t WS_LB = WS_SIN + (size_t)SEQ * 32 * 4;
constexpr size_t WS_CTR = WS_LB + 4096;
constexpr size_t WS_BAR = al256(WS_CTR + 256);
constexpr size_t WS_PH = al256(WS_BAR + 16384);
constexpr size_t WS_PR = WS_PH + (size_t)TTOK * NHC * 2;
constexpr size_t WS_END = WS_PR + (size_t)TTOK * NRC * 2;
constexpr size_t WS_Q = WS_PH;
constexpr size_t WS_KV = WS_Q + (size_t)TTOK * NQ * 2;
constexpr size_t WS_KPE = WS_KV + (size_t)TTOK * NKV * 2;
constexpr size_t WS_T1 = WS_PH;
constexpr size_t WS_MG = WS_T1 + (size_t)TTOK * 1024 * 2;
static_assert(WS_END <= (size_t)1073741824, "workspace map must fit 1 GiB");
static_assert(WS_KPE + (size_t)TTOK * 64 * 2 <= WS_PR && WS_MG + (size_t)TTOK * 1024 * 2 <= WS_PR, "overlays fit inside PH");
constexpr size_t OUT_H_OFF = (size_t)TTOK * DM * 2;
constexpr int YB_OFF_EL = TTOK * DM;

constexpr int LDS_BYTES = 147456;

__device__ __forceinline__ unsigned f2bf(float f) { unsigned u = __builtin_bit_cast(unsigned, f); return (u + 0x7fffu + ((u >> 16) & 1u)) >> 16; }
__device__ __forceinline__ unsigned pk2(float lo, float hi) { return f2bf(lo) | (f2bf(hi) << 16); }
typedef float f32x2_t __attribute__((ext_vector_type(2))); typedef __bf16 bf16x2_t __attribute__((ext_vector_type(2)));
__device__ __forceinline__ unsigned cvtpk_s(float lo, float hi) { f32x2_t v = {lo, hi}; bf16x2_t b = __builtin_convertvector(v, bf16x2_t); return __builtin_bit_cast(unsigned, b); }
__device__ __forceinline__ float bf2f(unsigned short b) { return __builtin_bit_cast(float, (unsigned)b << 16); }
__device__ __forceinline__ float bflo(unsigned w) { return __builtin_bit_cast(float, w << 16); }
__device__ __forceinline__ float bfhi(unsigned w) { return __builtin_bit_cast(float, w & 0xffff0000u); }
__device__ __forceinline__ float sigmoidf_(float x) { return __builtin_amdgcn_rcpf(1.f + __expf(-x)); }
__device__ __forceinline__ float siluf_(float x) { return x * __builtin_amdgcn_rcpf(1.f + __expf(-x)); }
__device__ __forceinline__ float wave_sum(float v) {
#pragma unroll
    for (int o = 1; o < 64; o <<= 1) v += __shfl_xor(v, o);
    return v;
}
__device__ __forceinline__ float wave_max(float v) {
#pragma unroll
    for (int o = 1; o < 64; o <<= 1) v = fmaxf(v, __shfl_xor(v, o));
    return v;
}
#define LDS_WAIT() asm volatile("s_waitcnt lgkmcnt(0)" ::: "memory")
#define LAUNDER(v) asm volatile("" : "+v"(v))
__device__ __forceinline__ int lane_id_v() { int l; asm volatile("v_mbcnt_lo_u32_b32 %0, -1, 0\n\tv_mbcnt_hi_u32_b32 %0, -1, %0" : "=v"(l)); return l; }
__device__ __forceinline__ int wave_id_s() { int w = (int)threadIdx.x >> 6; return __builtin_amdgcn_readfirstlane(w); }

namespace pg8 {
constexpr int BM = 256, BK = 64, HALF = 128, HTB = HALF * BK * 2, STAGE_BYTES = 8 * HTB, NXCD = 8, WGM = 8;
__host__ __device__ __forceinline__ int lds_byte(int r, int c) { const int st = (r >> 4) * 2 + (c >> 5), rr = r & 15, cc = c & 31, ob = rr * 64 + cc * 2; return st * 1024 + (ob ^ (((ob >> 9) & 1) << 5)); }
__host__ __device__ __forceinline__ void stage_rc(int b, int& R, int& C) { const int st = b / 1024, sb = b % 1024, swz = sb ^ (((sb >> 9) & 1) << 5); R = (st >> 1) * 16 + swz / 64; C = (st & 1) * 32 + (swz % 64) / 2; }
__host__ __device__ __forceinline__ int perm32(int rho) { const int n = rho >> 4, i = rho & 15; return 8 * (i >> 2) + 4 * n + (i & 3); }

struct Unit { int pm, pn, acol; };
struct Gemm { const bf16_t* A; const bf16_t* Bt; int lda, ldb, K; };

struct TileOrder {
    int nM, nN, nwg, G, c;
    __device__ void init(int M, int N, int G_, int c_) { nM = M / BM; nN = N / BM; nwg = nM * nN; G = G_; c = c_; }
    __device__ bool tile(int i, int& pm, int& pn) const {
        const long L = (long)i * G + c; if (L >= nwg) return false;
        int wgid = (int)L; { const int q = nwg / NXCD, r = nwg % NXCD, xcd = wgid % NXCD, off = wgid / NXCD; wgid = (xcd < r ? xcd * (q + 1) : r * (q + 1) + (xcd - r) * q) + off; }
        const int nig = WGM * nN, gid = wgid / nig, fm = gid * WGM, gsz = (nM - fm) < WGM ? (nM - fm) : WGM;
        pm = fm + ((wgid % nig) % gsz); pn = (wgid % nig) / gsz; return true;
    }
};
struct SchedPlain { TileOrder o; int per, rep; __device__ bool next(int i, Unit& u) const { int pm, pn; if (rep > 1) { if (i >= per * rep) return false; i = i % per; } if (!o.tile(i, pm, pn)) return false; u.pm = pm; u.pn = pn; u.acol = 0; return true; } };
struct SchedRow { int pm; __device__ bool next(int i, Unit& u) const { if (i >= 4) return false; u.pm = pm; u.pn = i; u.acol = 0; return true; } };
struct SchedAB { TileOrder o; int per, rep; __device__ bool next(int i, Unit& u) const { int pm, pn; if (rep > 1) { if (i >= per * rep) return false; i = i % per; } if (!o.tile(i >> 1, pm, pn)) return false; const int w = i & 1; u.pm = pm; u.pn = pn + 4 * w; u.acol = YB_OFF_EL * w; return true; } };

__device__ __forceinline__ unsigned cvt_pk_bf16(float lo, float hi) { unsigned r; asm volatile("v_cvt_pk_bf16_f32 %0, %1, %2" : "=v"(r) : "v"(lo), "v"(hi)); return r; }

struct EpiBf16 {
    static constexpr bool PERM = true;
    bf16_t* O; int ldc;
    __device__ __forceinline__ void operator()(const f32x4 (&acc)[2][2][4][2], const Unit& u, int wr, int wc, int fr, int fq) const {
        const int row0 = u.pm * BM + wr * 64 + fr; const int col0 = u.pn * BM + wc * 32 + 8 * fq;
#pragma unroll
        for (int ai = 0; ai < 2; ++ai)
#pragma unroll
            for (int m = 0; m < 4; ++m) { bf16_t* rowp = O + (size_t)(row0 + ai * HALF + m * 16) * ldc + col0;
#pragma unroll
                for (int bj = 0; bj < 2; ++bj) { const f32x4 v0 = acc[ai][bj][m][0], v1 = acc[ai][bj][m][1];
                    u32x4 w; w.x = cvt_pk_bf16(v0[0], v0[1]); w.y = cvt_pk_bf16(v0[2], v0[3]); w.z = cvt_pk_bf16(v1[0], v1[1]); w.w = cvt_pk_bf16(v1[2], v1[3]);
                    *(u32x4*)(rowp + bj * HALF) = w; } }
    }
};

struct EpiQRope {
    static constexpr bool PERM = true;
    bf16_t* O; const float* cosT; const float* sinT;
    __device__ __forceinline__ void operator()(const f32x4 (&acc)[2][2][4][2], const Unit& u, int wr, int wc, int fr, int fq) const {
        const int row0 = u.pm * BM + wr * 64 + fr; const int col0 = u.pn * BM + wc * 32 + 8 * fq; const bool rope = u.pn >= 4;
#pragma unroll
        for (int ai = 0; ai < 2; ++ai)
#pragma unroll
            for (int m = 0; m < 4; ++m) { const int row = row0 + ai * HALF + m * 16; bf16_t* rowp = O + (size_t)row * NQ + col0;
                f32x4 a0 = acc[ai][0][m][0], a1 = acc[ai][0][m][1], b0 = acc[ai][1][m][0], b1 = acc[ai][1][m][1];
                if (rope) { const int pos = row & (SEQ - 1); const f32x4 c0 = *(const f32x4*)(cosT + pos * 32 + 8 * fq), c1 = *(const f32x4*)(cosT + pos * 32 + 8 * fq + 4);
                    const f32x4 s0 = *(const f32x4*)(sinT + pos * 32 + 8 * fq), s1 = *(const f32x4*)(sinT + pos * 32 + 8 * fq + 4);
                    const f32x4 x0 = a0 * c0 - b0 * s0, x1 = a1 * c1 - b1 * s1, y0 = b0 * c0 + a0 * s0, y1 = b1 * c1 + a1 * s1; a0 = x0; a1 = x1; b0 = y0; b1 = y1; }
                u32x4 w; w.x = cvt_pk_bf16(a0[0], a0[1]); w.y = cvt_pk_bf16(a0[2], a0[3]); w.z = cvt_pk_bf16(a1[0], a1[1]); w.w = cvt_pk_bf16(a1[2], a1[3]); *(u32x4*)rowp = w;
                w.x = cvt_pk_bf16(b0[0], b0[1]); w.y = cvt_pk_bf16(b0[2], b0[3]); w.z = cvt_pk_bf16(b1[0], b1[1]); w.w = cvt_pk_bf16(b1[2], b1[3]); *(u32x4*)(rowp + HALF) = w; }
    }
};
struct EpiGate {
    static constexpr bool PERM = true;
    const bf16_t* P; const float* bgate; bf16_t* T1; bf16_t* MG;
    __device__ __forceinline__ void operator()(const f32x4 (&acc)[2][2][4][2], const Unit& u, int wr, int wc, int fr, int fq) const {
        const int which = u.pn >> 2; const int row0 = u.pm * BM + wr * 64 + fr; const int col0 = (u.pn & 3) * BM + wc * 32 + 8 * fq;
#pragma unroll
        for (int bj = 0; bj < 2; ++bj) { const int col = col0 + bj * HALF;
            const f32x4 b0 = *(const f32x4*)(bgate + which * 1024 + col), b1 = *(const f32x4*)(bgate + which * 1024 + col + 4);
#pragma unroll
            for (int ai = 0; ai < 2; ++ai) { u32x4 glv[4], tv[4];
#pragma unroll
                for (int m = 0; m < 4; ++m) { const size_t row = (size_t)(row0 + ai * HALF + m * 16);
                    glv[m] = *(const u32x4*)(P + row * NRC + R_GL + which * 1024 + col);
                    tv[m] = which ? *(const u32x4*)(T1 + row * 1024 + col) : (u32x4){0u, 0u, 0u, 0u}; }
#pragma unroll
                for (int m = 0; m < 4; ++m) { const size_t row = (size_t)(row0 + ai * HALF + m * 16);
                    const u32x4 gl = glv[m], t = tv[m];
                    const f32x4 v0 = acc[ai][bj][m][0], v1 = acc[ai][bj][m][1];
                    float r[8];
                    r[0] = sigmoidf_(bflo(gl.x) + b0[0]) * v0[0]; r[1] = sigmoidf_(bfhi(gl.x) + b0[1]) * v0[1];
                    r[2] = sigmoidf_(bflo(gl.y) + b0[2]) * v0[2]; r[3] = sigmoidf_(bfhi(gl.y) + b0[3]) * v0[3];
                    r[4] = sigmoidf_(bflo(gl.z) + b1[0]) * v1[0]; r[5] = sigmoidf_(bfhi(gl.z) + b1[1]) * v1[1];
                    r[6] = sigmoidf_(bflo(gl.w) + b1[2]) * v1[2]; r[7] = sigmoidf_(bfhi(gl.w) + b1[3]) * v1[3];
                    if (which == 0) { u32x4 w; w.x = cvt_pk_bf16(r[0], r[1]); w.y = cvt_pk_bf16(r[2], r[3]); w.z = cvt_pk_bf16(r[4], r[5]); w.w = cvt_pk_bf16(r[6], r[7]);
                        *(u32x4*)(T1 + row * 1024 + col) = w; }
                    else { u32x4 w; w.x = cvt_pk_bf16(r[0] + bflo(t.x), r[1] + bfhi(t.x)); w.y = cvt_pk_bf16(r[2] + bflo(t.y), r[3] + bfhi(t.y));
                        w.z = cvt_pk_bf16(r[4] + bflo(t.z), r[5] + bfhi(t.z)); w.w = cvt_pk_bf16(r[6] + bflo(t.w), r[7] + bfhi(t.w));
                        *(u32x4*)(MG + row * 1024 + col) = w; } } } }
    }
};
struct EpiResid {
    static constexpr bool PERM = false;
    const float* X; float* O;
    __device__ __forceinline__ void operator()(const f32x4 (&acc)[2][2][4][2], const Unit& u, int wr, int wc, int fr, int fq) const {
        const int row0 = u.pm * BM + wr * 64 + fr; const int col0 = u.pn * BM + wc * 32 + 4 * fq;
#pragma unroll
        for (int ai = 0; ai < 2; ++ai) { f32x4 xv[4][2][2];
#pragma unroll
            for (int m = 0; m < 4; ++m) { const size_t off = (size_t)(row0 + ai * HALF + m * 16) * 1024 + col0;
#pragma unroll
                for (int bj = 0; bj < 2; ++bj)
#pragma unroll
                    for (int n = 0; n < 2; ++n) xv[m][bj][n] = *(const f32x4*)(X + off + bj * HALF + n * 16); }
#pragma unroll
            for (int m = 0; m < 4; ++m) { const size_t off = (size_t)(row0 + ai * HALF + m * 16) * 1024 + col0;
#pragma unroll
                for (int bj = 0; bj < 2; ++bj)
#pragma unroll
                    for (int n = 0; n < 2; ++n) *(f32x4*)(O + off + bj * HALF + n * 16) = xv[m][bj][n] + acc[ai][bj][m][n]; } }
    }
};

template <class Epi, class Sched>
__device__ __forceinline__ void gemm_phase(LAS unsigned char* lds, const Gemm g, const Sched& S, const Epi& E, const int wave_s) {
    const int wid = wave_s;
    const int tid = wid * 64 + lane_id_v(), lane = tid & 63, wr = wid >> 2, wc = wid & 3, fr = lane & 15, fq = lane >> 4;
    const int K = g.K, nt = K / BK;
    unsigned voffA[2], voffB[2];
#pragma unroll
    for (int i = 0; i < 2; ++i) { int R, C; stage_rc(tid * 16 + i * 8192, R, C); const int Rb = Epi::PERM ? ((R & ~31) + perm32(R & 31)) : R;
        voffA[i] = (unsigned)(R * g.lda + C) * 2u; voffB[i] = (unsigned)(Rb * g.ldb + C) * 2u; }
    const size_t kstep = (size_t)(BK * 2);
    const size_t hstepA = (size_t)HALF * g.lda * 2, hstepB = (size_t)HALF * g.ldb * 2;
    const size_t tstepA = 2 * hstepA, tstepB = 2 * hstepB;
    const unsigned ldsw = (unsigned)wid * 1024u;
    const int aoff = lds_byte(wr * 64 + fr, fq * 8), boff = lds_byte(wc * 32 + fr, fq * 8);
#define PG8_SA(b, h) (((b) * 2 + (h)) * HTB)
#define PG8_SB(b, h) ((4 + (b) * 2 + (h)) * HTB)
#define PG8_STAGE(bufoff, gbase, voff) do { _Pragma("unroll") for (int _i = 0; _i < 2; ++_i) \
        __builtin_amdgcn_global_load_lds((const unsigned*)((const char*)(gbase) + (voff)[_i]), (LAS unsigned*)(lds + (bufoff) + ldsw + _i * 8192), 16, 0, 0); } while (0)
#define PG8_LDA(dst, b, h) do { _Pragma("unroll") for (int m = 0; m < 4; ++m) _Pragma("unroll") for (int k = 0; k < 2; ++k) dst[m][k] = *(const LAS bf16x8*)(lds + PG8_SA(b, h) + aoff + m * 2048 + k * 1024); } while (0)
#define PG8_LDB(dst, b, h) do { _Pragma("unroll") for (int n = 0; n < 2; ++n) _Pragma("unroll") for (int k = 0; k < 2; ++k) dst[n][k] = *(const LAS bf16x8*)(lds + PG8_SB(b, h) + boff + n * 2048 + k * 1024); } while (0)
#define PG8_MMA(ai, bj, At, Bt) do { __builtin_amdgcn_s_setprio(1); _Pragma("unroll") for (int m = 0; m < 4; ++m) _Pragma("unroll") for (int n = 0; n < 2; ++n) _Pragma("unroll") for (int k = 0; k < 2; ++k) \
        acc[ai][bj][m][n] = __builtin_amdgcn_mfma_f32_16x16x32_bf16(Bt[n][k], At[m][k], acc[ai][bj][m][n], 0, 0, 0); __builtin_amdgcn_s_setprio(0); } while (0)
#define PG8_WAIT_V(n) asm volatile("s_waitcnt vmcnt(" #n ")" ::: "memory")
#define PG8_WAIT_L(n) asm volatile("s_waitcnt lgkmcnt(" #n ")" ::: "memory")
#define PG8_BAR __builtin_amdgcn_s_barrier()
#define PG8_SCHED __builtin_amdgcn_sched_barrier(0)
    Unit cur, nxt; int ui = 0;
    if (!S.next(0, cur)) return;
    f32x4 acc[2][2][4][2];
#pragma unroll
    for (int a = 0; a < 2; ++a)
#pragma unroll
        for (int b = 0; b < 2; ++b)
#pragma unroll
            for (int m = 0; m < 4; ++m)
#pragma unroll
                for (int n = 0; n < 2; ++n) acc[a][b][m][n] = (f32x4){0.f, 0.f, 0.f, 0.f};
    bf16x8 At[4][2], B0[2][2], B1[2][2];
    const char* cA = (const char*)g.A + (size_t)cur.pm * tstepA + (size_t)cur.acol * 2; const char* cB = (const char*)g.Bt + (size_t)cur.pn * tstepB;
    PG8_STAGE(PG8_SB(0, 0), cB, voffB); PG8_STAGE(PG8_SB(0, 1), cB + hstepB, voffB); PG8_STAGE(PG8_SA(0, 0), cA, voffA); PG8_STAGE(PG8_SA(0, 1), cA + hstepA, voffA);
    if (wr == 1) PG8_BAR;
    PG8_WAIT_V(2); PG8_BAR;
    PG8_STAGE(PG8_SB(1, 0), cB + kstep, voffB); PG8_STAGE(PG8_SA(1, 0), cA + kstep, voffA); PG8_STAGE(PG8_SB(1, 1), cB + hstepB + kstep, voffB);
    PG8_WAIT_V(6); PG8_BAR;
    for (;;) {
        const bool has_next = S.next(ui + 1, nxt);
        const char* nA = has_next ? (const char*)g.A + (size_t)nxt.pm * tstepA + (size_t)nxt.acol * 2 : cA; const char* nB = has_next ? (const char*)g.Bt + (size_t)nxt.pn * tstepB : cB;
#pragma unroll 1
        for (int t = 0; t < nt; t += 2) {
            const bool last = (t == nt - 2);
            const char* a1 = cA + (size_t)(t + 1) * kstep;
            const char* a2 = last ? nA : cA + (size_t)(t + 2) * kstep; const char* b2 = last ? nB : cB + (size_t)(t + 2) * kstep;
            const char* a3 = a2 + kstep; const char* b3 = b2 + kstep;
            PG8_LDB(B0, 0, 0); PG8_LDB(B1, 0, 1); PG8_SCHED; PG8_LDA(At, 0, 0); PG8_STAGE(PG8_SA(1, 1), a1 + hstepA, voffA);
            PG8_WAIT_V(8); PG8_WAIT_L(0); PG8_BAR; PG8_MMA(0, 0, At, B0); PG8_MMA(0, 1, At, B1); PG8_BAR; PG8_SCHED;
            PG8_LDA(At, 0, 1); PG8_STAGE(PG8_SB(0, 0), b2, voffB); PG8_STAGE(PG8_SB(0, 1), b2 + hstepB, voffB); PG8_STAGE(PG8_SA(0, 0), a2, voffA);
            PG8_WAIT_V(8); PG8_WAIT_L(0); PG8_BAR; PG8_MMA(1, 0, At, B0); PG8_MMA(1, 1, At, B1); PG8_BAR; PG8_SCHED;
            PG8_LDB(B0, 1, 0); PG8_LDB(B1, 1, 1); PG8_SCHED; PG8_LDA(At, 1, 0); PG8_STAGE(PG8_SA(0, 1), a2 + hstepA, voffA);
            PG8_WAIT_V(8); PG8_WAIT_L(0); PG8_BAR; PG8_MMA(0, 0, At, B0); PG8_MMA(0, 1, At, B1); PG8_BAR; PG8_SCHED;
            PG8_LDA(At, 1, 1); PG8_STAGE(PG8_SB(1, 0), b3, voffB); PG8_STAGE(PG8_SB(1, 1), b3 + hstepB, voffB); PG8_STAGE(PG8_SA(1, 0), a3, voffA);
            PG8_WAIT_V(8); PG8_WAIT_L(0); PG8_BAR; PG8_MMA(1, 0, At, B0); PG8_MMA(1, 1, At, B1); PG8_BAR; PG8_SCHED;
        }
        if (wr == 0) PG8_BAR;
        E(acc, cur, wr, wc, fr, fq);
        if (!has_next) break;
#pragma unroll
        for (int a = 0; a < 2; ++a)
#pragma unroll
            for (int b = 0; b < 2; ++b)
#pragma unroll
                for (int m = 0; m < 4; ++m)
#pragma unroll
                    for (int n = 0; n < 2; ++n) acc[a][b][m][n] = (f32x4){0.f, 0.f, 0.f, 0.f};
        cur = nxt; cA = nA; cB = nB; ++ui;
        if (wr == 1) PG8_BAR;
    }
    PG8_WAIT_V(0);
    PG8_BAR;
#undef PG8_SA
#undef PG8_SB
#undef PG8_STAGE
#undef PG8_LDA
#undef PG8_LDB
#undef PG8_MMA
#undef PG8_WAIT_V
#undef PG8_WAIT_L
#undef PG8_BAR
#undef PG8_SCHED
}
}

__device__ __forceinline__ int qmap(int n) { const int h = n / 192, d = n % 192; if (d < 128) return h * 128 + d; const int i = d - 128; return 1024 + (h >> 2) * 256 + (i >> 5) * 128 + (h & 3) * 32 + (i & 31); }
template <bool QMAP = false>
__device__ __forceinline__ void transpose_item(const float* W, int K, int N, bf16_t* WT, int row_off, const float* gain, LAS float* scr, int item, int lane) {
    const int nblk = N / 32, kb = item / nblk, nb = item % nblk, k0 = 64 * kb, n0 = 32 * nb; const int d0 = QMAP ? qmap(n0) : n0;
#pragma unroll 8
    for (int i = 0; i < 32; ++i) { const int kk = 2 * i + (lane >> 5); const float gk = gain ? gain[k0 + kk] : 1.f; scr[kk * 33 + (lane & 31)] = W[(size_t)(k0 + kk) * N + n0 + (lane & 31)] * gk; }
    LDS_WAIT(); asm volatile("" ::: "memory");
    const int c = lane & 7;
#pragma unroll
    for (int j = 0; j < 4; ++j) { const int n = (lane >> 3) + 8 * j; const LAS float* s = scr + (8 * c) * 33 + n;
        u32x4 o; o.x = pk2(s[0 * 33], s[1 * 33]); o.y = pk2(s[2 * 33], s[3 * 33]); o.z = pk2(s[4 * 33], s[5 * 33]); o.w = pk2(s[6 * 33], s[7 * 33]);
        *(u32x4*)(WT + (size_t)(row_off + d0 + n) * K + k0 + 8 * c) = o; }
    LDS_WAIT(); asm volatile("" ::: "memory");
}

struct Args { const float* in[14]; float* out; unsigned char* ws; float inv[32]; };

namespace att {
typedef short s16x4 __attribute__((ext_vector_type(4)));
typedef float f32x16 __attribute__((ext_vector_type(16)));
constexpr int NW = 8, QBLK = 32, KVBLK = 64, QB = 256;
constexpr int SHM_V = 16384, SHM_K = 17408, SHM_R = 9216;
constexpr int OFF_V = 0, OFF_K = 3 * SHM_V,     OFF_R = OFF_K + 2 * SHM_K, OFF_WS = OFF_R + 2 * SHM_R, OFF_QR = OFF_WS + NW * 64 * 4, ATT_LDS = OFF_QR + NW * 4096;
constexpr float THR = 8.f;
#define KSWZ(row, colB) ((row) * 272 + (colB))
#define RSWZ(row, colB) ((row) * 144 + (colB))
#define SBAR() __builtin_amdgcn_sched_barrier(0)
__device__ __forceinline__ int v_st(int k, int c) { const int kk = (k & ~0xC) | ((k & 4) << 1) | ((k & 8) >> 1); return ((kk >> 3) * 4 + (c >> 5)) * 512 + ((kk & 7) * 32 + (c & 31)) * 2; }
__device__ __forceinline__ int v_rd_base(int lane) { return ((lane & 3) << 3) | (((lane >> 2) & 3) << 6) | (((lane >> 4) & 1) << 5) | (((lane >> 5) & 1) << 8); }
constexpr int v_rd_off(int d0, int ks, int half) { return d0 * 512 + ks * 4096 + half * 2048; }
__device__ __forceinline__ int crow(int r, int hi) { return (r & 3) + 8 * (r >> 2) + 4 * hi; }
__device__ __forceinline__ unsigned cvtpk(float lo, float hi) { unsigned r; asm volatile("v_cvt_pk_bf16_f32 %0, %1, %2" : "=v"(r) : "v"(lo), "v"(hi)); return r; }
__device__ __forceinline__ bf16x8 load8(const bf16_t* p) { return *reinterpret_cast<const bf16x8*>(p); }
__device__ __forceinline__ void mask_tile(f32x16& p0, f32x16& p1, int dq) {
    const float NEG = -__builtin_inff();
#pragma unroll
    for (int r = 0; r < 16; ++r) { const int c = (r & 3) + 8 * (r >> 2); if (dq - c < 0) p0[r] = NEG; if (dq - c - 32 < 0) p1[r] = NEG; }
}
__device__ __forceinline__ void partialSM(f32x16& p0, f32x16& p1, float& m_reg, float& mn, float& alpha) {
    float pmax = p0[0];
#pragma unroll
    for (int r = 1; r < 16; ++r) pmax = fmaxf(pmax, p0[r]);
#pragma unroll
    for (int r = 0; r < 16; ++r) pmax = fmaxf(pmax, p1[r]);
    { auto rr = __builtin_amdgcn_permlane32_swap(__float_as_uint(pmax), __float_as_uint(pmax), false, false);
      pmax = fmaxf(__uint_as_float(rr[0]), __uint_as_float(rr[1])); }
    constexpr float C2 = 1.4426950408889634f * ATT_SCALE;
    if (__builtin_expect(__all((pmax - m_reg) * ATT_SCALE <= THR), 1)) { mn = m_reg; alpha = 1.f; }
    else { mn = fmaxf(m_reg, pmax); alpha = __builtin_amdgcn_exp2f((m_reg - mn) * C2); m_reg = mn; }
    const float mnL = -mn * C2;
#pragma unroll
    for (int r = 0; r < 16; ++r) p0[r] = fmaf(p0[r], C2, mnL);
#pragma unroll
    for (int r = 0; r < 16; ++r) p1[r] = fmaf(p1[r], C2, mnL);
#pragma unroll
    for (int r = 0; r < 16; ++r) p0[r] = __builtin_amdgcn_exp2f(p0[r]);
}
__device__ __forceinline__ void finishSM(f32x16& p0, f32x16& p1, float alpha, float& l_reg, bf16x8& pa0, bf16x8& pa1, bf16x8& pa2, bf16x8& pa3) {
#pragma unroll
    for (int r = 0; r < 16; ++r) p1[r] = __builtin_amdgcn_exp2f(p1[r]);
    float ps = 0;
#pragma unroll
    for (int r = 0; r < 16; ++r) ps += p0[r];
#pragma unroll
    for (int r = 0; r < 16; ++r) ps += p1[r];
    { auto rr = __builtin_amdgcn_permlane32_swap(__float_as_uint(ps), __float_as_uint(ps), false, false);
      ps = __uint_as_float(rr[0]) + __uint_as_float(rr[1]); }
    l_reg = l_reg * alpha + ps;
#define PK4(P, B_, OUT) do { unsigned a0 = cvtpk(P[B_+0], P[B_+1]), a1 = cvtpk(P[B_+2], P[B_+3]);                          \
        unsigned b0 = cvtpk(P[B_+4], P[B_+5]), b1 = cvtpk(P[B_+6], P[B_+7]);                                             \
        auto r0 = __builtin_amdgcn_permlane32_swap(a0, b0, false, false); auto r1 = __builtin_amdgcn_permlane32_swap(a1, b1, false, false); \
        u32x4 w = {r0[0], r1[0], r0[1], r1[1]}; OUT = *reinterpret_cast<bf16x8*>(&w); } while (0)
    PK4(p0, 0, pa0); PK4(p0, 8, pa1); PK4(p1, 0, pa2); PK4(p1, 8, pa3);
#undef PK4
}
template <int KB>
__device__ __forceinline__ void qkt(f32x16& p0, f32x16& p1, const LAS char* lds, int r32, int hi, const bf16x8* qr, const LAS char* qrb) {
    p0 = f32x16{}; p1 = f32x16{};
    { const LAS char* kbp = lds + OFF_K + KB * SHM_K + KSWZ(r32, hi * 16);
#pragma unroll
    for (int d0 = 0; d0 < 8; ++d0) { const LAS char* a = kbp + d0 * 32;
        const bf16x8 b0 = *reinterpret_cast<const LAS bf16x8*>(a);
        const bf16x8 b1 = *reinterpret_cast<const LAS bf16x8*>(a + 32 * 272);
        p0 = __builtin_amdgcn_mfma_f32_32x32x16_bf16(b0, qr[d0], p0, 0, 0, 0);
        p1 = __builtin_amdgcn_mfma_f32_32x32x16_bf16(b1, qr[d0], p1, 0, 0, 0); } }
    { const LAS char* rb = lds + OFF_R + KB * SHM_R + RSWZ(r32, hi * 16);
#pragma unroll
    for (int d0 = 0; d0 < 4; ++d0) { const LAS char* a = rb + d0 * 32;
        const bf16x8 b0 = *reinterpret_cast<const LAS bf16x8*>(a);
        const bf16x8 b1 = *reinterpret_cast<const LAS bf16x8*>(a + 32 * 144);
        const bf16x8 qv = *reinterpret_cast<const LAS bf16x8*>(qrb + d0 * 1024);
        p0 = __builtin_amdgcn_mfma_f32_32x32x16_bf16(b0, qv, p0, 0, 0, 0);
        p1 = __builtin_amdgcn_mfma_f32_32x32x16_bf16(b1, qv, p1, 0, 0, 0); } }
}
template <int VB>
__device__ __forceinline__ void pv_tile(f32x16* o, int vb0, bf16x8 pa0, bf16x8 pa1, bf16x8 pa2, bf16x8 pa3) {
#define TRRD(dst, off) asm volatile("ds_read_b64_tr_b16 %0, %1 offset:%2" : "=&v"(dst) : "v"(vb0), "i"(off) : "memory")
#define PV_D0(d0) do { s16x4 l0, l1, l2, l3, h0, h1, h2, h3; constexpr int b_ = OFF_V + VB * SHM_V + v_rd_off(d0, 0, 0); \
        TRRD(l0, b_); TRRD(h0, b_ + 2048); TRRD(l1, b_ + 4096); TRRD(h1, b_ + 6144); TRRD(l2, b_ + 8192); TRRD(h2, b_ + 10240); TRRD(l3, b_ + 12288); TRRD(h3, b_ + 14336); \
        asm volatile("s_waitcnt lgkmcnt(0)" ::: "memory"); SBAR();   \
        o[d0] = __builtin_amdgcn_mfma_f32_32x32x16_bf16(pa0, (bf16x8){l0[0], l0[1], l0[2], l0[3], h0[0], h0[1], h0[2], h0[3]}, o[d0], 0, 0, 0);   \
        o[d0] = __builtin_amdgcn_mfma_f32_32x32x16_bf16(pa1, (bf16x8){l1[0], l1[1], l1[2], l1[3], h1[0], h1[1], h1[2], h1[3]}, o[d0], 0, 0, 0);   \
        o[d0] = __builtin_amdgcn_mfma_f32_32x32x16_bf16(pa2, (bf16x8){l2[0], l2[1], l2[2], l2[3], h2[0], h2[1], h2[2], h2[3]}, o[d0], 0, 0, 0);   \
        o[d0] = __builtin_amdgcn_mfma_f32_32x32x16_bf16(pa3, (bf16x8){l3[0], l3[1], l3[2], l3[3], h3[0], h3[1], h3[2], h3[3]}, o[d0], 0, 0, 0); } while (0)
    PV_D0(0); PV_D0(1); PV_D0(2); PV_D0(3);
#undef PV_D0
#undef TRRD
}
struct BlockRef { int bl, h, qb; };
struct Bases { const bf16_t* Q; const bf16_t* KV; const bf16_t* KPE; const bf16_t* P; bf16_t* Y; };
#define R_K(r) (B.KV + (size_t)(r).bl * SEQ * NKV + (r).h * 256)
#define R_V(r) (B.KV + (size_t)(r).bl * SEQ * NKV + (r).h * 256 + 128)
#define R_R(r) (B.KPE + (size_t)(r).bl * SEQ * 64)
#define R_QN(r) (B.Q + ((size_t)(r).bl * SEQ + (size_t)(r).qb * QB) * NQ + (r).h * 128)
#define R_QR(r) (B.Q + ((size_t)(r).bl * SEQ + (size_t)(r).qb * QB) * NQ + 1024 + ((r).h >> 2) * 256 + ((r).h & 3) * 32)
#define R_Z(r) (B.P + ((size_t)(r).bl * SEQ + (size_t)(r).qb * QB) * NRC + R_MZ + (r).h * 128)
#define R_O(r) (B.Y + ((size_t)(r).bl * SEQ + (size_t)(r).qb * QB) * 1024 + (r).h * 128)
struct Seam { bf16x8 qr[8]; bf16x8 st_v0, st_v1, st_k0, st_k1, st_r; };
#define VMW() asm volatile("s_waitcnt vmcnt(0)" ::: "memory")
#define VMWN(n) asm volatile("s_waitcnt vmcnt(%0)" :: "i"(n) : "memory")
#define LDU8(ubase, off) (*(const bf16x8*)((const char*)(ubase) + (off)))
#define SLOAD_H(Kp, Vp, Rp, k0) do { int t_ = tid; LAUNDER(t_); const unsigned kvoff_ = (unsigned)((t_ >> 4) * NKV + (t_ & 15) * 8) * 2u, roff_ = (unsigned)((t_ >> 3) * 64 + (t_ & 7) * 8) * 2u; \
                         S.st_v0 = LDU8((Vp) + (size_t)(k0) * NKV, kvoff_); S.st_v1 = LDU8((Vp) + (size_t)((k0) + 32) * NKV, kvoff_); \
                         S.st_k0 = LDU8((Kp) + (size_t)(k0) * NKV, kvoff_); S.st_k1 = LDU8((Kp) + (size_t)((k0) + 32) * NKV, kvoff_); \
                         S.st_r = LDU8((Rp) + (size_t)(k0) * 64, roff_); } while (0)
#define SWRITE_HK(bf) do { int t_ = tid; LAUNDER(t_); const int kws_ = KSWZ(t_ >> 4, (t_ & 15) * 16), rws_ = RSWZ(t_ >> 3, (t_ & 7) * 16); \
                           *(LAS bf16x8*)(lds + OFF_K + (bf) * SHM_K + kws_) = S.st_k0; *(LAS bf16x8*)(lds + OFF_K + (bf) * SHM_K + kws_ + 32 * 272) = S.st_k1; \
                           *(LAS bf16x8*)(lds + OFF_R + (bf) * SHM_R + rws_) = S.st_r; } while (0)
#define SWRITE_HV(bf) do { int t_ = tid; LAUNDER(t_); const int vst0_ = v_st(t_ >> 4, (t_ & 15) * 8), vst1_ = v_st(32 + (t_ >> 4), (t_ & 15) * 8); \
                           *(LAS bf16x8*)(lds + OFF_V + (bf) * SHM_V + vst0_) = S.st_v0; *(LAS bf16x8*)(lds + OFF_V + (bf) * SHM_V + vst1_) = S.st_v1; } while (0)
#define SWRITE_H(bf) do { SWRITE_HV(bf); SWRITE_HK(bf); } while (0)
#define QOFF_ ({ int t_ = tid; LAUNDER(t_); (unsigned)((t_ & 31) * NQ + ((t_ >> 5) & 1) * 8) * 2u; })
#define QLOAD(B_) do { const bf16_t* qn_ = R_QN(B_) + (size_t)(wid * QBLK) * NQ; const unsigned qoff_ = QOFF_; \
        _Pragma("unroll") for (int d0 = 0; d0 < 8; ++d0) S.qr[d0] = LDU8(qn_ + d0 * 16, qoff_); } while (0)
#define QLOAD_R(B_) const bf16_t* qr_ = R_QR(B_) + (size_t)(wid * QBLK) * NQ; const unsigned qoffr_ = QOFF_; \
        const bf16x8 qt0 = LDU8(qr_, qoffr_), qt1 = LDU8(qr_ + 16, qoffr_), qt2 = LDU8(qr_ + 128, qoffr_), qt3 = LDU8(qr_ + 144, qoffr_)
#define QWRITE_R() do { *(LAS bf16x8*)(qrb) = qt0; *(LAS bf16x8*)(qrb + 1024) = qt1; *(LAS bf16x8*)(qrb + 2048) = qt2; *(LAS bf16x8*)(qrb + 3072) = qt3; } while (0)
__device__ __forceinline__ void attn_prime(const Bases& B, const BlockRef& cur, LAS char* lds, Seam& S, int tid) {
    const int wid = __builtin_amdgcn_readfirstlane(tid >> 6), lane = tid & 63, r32 = lane & 31, hi = lane >> 5;
    LAS char* qrb = lds + OFF_QR + wid * 4096 + lane * 16;
    QLOAD(cur); QLOAD_R(cur);
    SLOAD_H(R_K(cur), R_V(cur), R_R(cur), 0); VMW(); SWRITE_HK(0); QWRITE_R();
    __syncthreads();
}
__device__ __forceinline__ void attn_block(const Bases& B, const BlockRef& cur, const BlockRef& nxt, LAS char* lds, Seam& S, int tid) {
    const int wid = __builtin_amdgcn_readfirstlane(tid >> 6), lane = tid & 63, r32 = lane & 31, hi = lane >> 5;
    const int P0 = cur.qb * QB, NT = (P0 + QB - 1) / KVBLK + 1;
    const int qlo = P0 + wid * QBLK, qm = qlo + r32 - 4 * hi;
    LAS float* ws = (LAS float*)(lds + OFF_WS) + wid * 64; LAS float* li_l = ws; LAS float* al_l = ws + 32;
    float m_reg = -1e30f, l_reg = 0; f32x16 o[4] = {};
    const int vb0 = (int)(unsigned)(uintptr_t)lds + v_rd_base(lane);
    LAS char* qrb = lds + OFF_QR + wid * 4096 + lane * 16;
#define Kh R_K(cur)
#define Vh R_V(cur)
#define Rh R_R(cur)
#define RESC(a) do { if (__any((a) < 1.f)) { if (hi == 0) al_l[r32] = (a); asm volatile("s_waitcnt lgkmcnt(0)" ::: "memory");              \
                     for (int d_ = 0; d_ < 4; ++d_) for (int r = 0; r < 16; ++r) o[d_][r] *= al_l[crow(r, hi)]; } } while (0)
#define KBASE(t) ((t) * KVBLK)
#define MASKT(P0_, P1_, t) do { const int kb_ = KBASE(t); if (kb_ + KVBLK - 1 > qlo) mask_tile(P0_, P1_, qm - kb_); } while (0)
    f32x16 pA0, pA1, pB0, pB1; float mnA, mnB, alA, alB; bf16x8 pa0, pa1, pa2, pa3;
    SWRITE_HV(0); SBAR();
    if (NT > 1) { SLOAD_H(Kh, Vh, Rh, KBASE(1)); }
    SBAR(); qkt<0>(pA0, pA1, lds, r32, hi, S.qr, qrb);
    MASKT(pA0, pA1, 0); partialSM(pA0, pA1, m_reg, mnA, alA);
    if (NT > 1) { VMW(); SWRITE_H(1); }
    __syncthreads();
    int vr = 0;
#define HALF_STEP(PX0, PX1, mnX, alX, PY0, PY1, alY, t, KB, SB) do {                                                          \
        SBAR(); qkt<KB>(PX0, PX1, lds, r32, hi, S.qr, qrb);                                                                   \
        finishSM(PY0, PY1, alY, l_reg, pa0, pa1, pa2, pa3); SBAR();                                                           \
        if ((t) + 1 < NT) { SLOAD_H(Kh, Vh, Rh, KBASE((t) + 1)); SBAR(); }                                                    \
        pv_tile<0>(o, vb0 + vr * SHM_V, pa0, pa1, pa2, pa3); MASKT(PX0, PX1, (t)); partialSM(PX0, PX1, m_reg, mnX, alX);      \
        { const int vw = vr == 0 ? 2 : vr - 1;                                                                                \
          if ((t) + 1 < NT) { VMW(); SWRITE_HK(SB); SWRITE_HV(vw); } }                                                        \
        RESC(alX); __syncthreads(); vr = vr == 2 ? 0 : vr + 1; } while (0)
    for (int t = 1; t + 1 < NT; t += 2) {
        HALF_STEP(pB0, pB1, mnB, alB, pA0, pA1, alA, t, 1, 0);
        HALF_STEP(pA0, pA1, mnA, alA, pB0, pB1, alB, t + 1, 0, 1);
    }
    const bool even = (NT & 1) == 0;
    if (even) { SBAR(); qkt<1>(pB0, pB1, lds, r32, hi, S.qr, qrb); SBAR(); }
    SLOAD_H(R_K(nxt), R_V(nxt), R_R(nxt), 0); SBAR();
    QLOAD(nxt);
    SBAR();
    finishSM(pA0, pA1, alA, l_reg, pa0, pa1, pa2, pa3); SBAR();
    pv_tile<0>(o, vb0 + vr * SHM_V, pa0, pa1, pa2, pa3);
    if (even) { MASKT(pB0, pB1, NT - 1); partialSM(pB0, pB1, m_reg, mnB, alB); __syncthreads(); RESC(alB);
        finishSM(pB0, pB1, alB, l_reg, pa0, pa1, pa2, pa3); SBAR(); pv_tile<0>(o, vb0 + (vr == 2 ? 0 : vr + 1) * SHM_V, pa0, pa1, pa2, pa3); }
    SBAR(); VMWN(8); SWRITE_HK(0); SBAR();
    QLOAD_R(nxt);
    if (hi == 0) li_l[r32] = l_reg; asm volatile("s_waitcnt lgkmcnt(0)" ::: "memory");
    bf16_t* Ow = R_O(cur) + (size_t)(wid * QBLK) * 1024; const bf16_t* Zw = R_Z(cur) + (size_t)(wid * QBLK) * NRC;
    int l_ = tid; LAUNDER(l_); const int hi_ = (l_ >> 5) & 1, r32_ = l_ & 31;
    const unsigned zoff = (unsigned)(4 * hi_ * NRC + r32_) * 2u, ooff = (unsigned)(4 * hi_ * 1024 + r32_) * 2u;
    unsigned short zr[16][4];
#pragma unroll
    for (int r = 0; r < 16; ++r) { const int rc = (r & 3) + 8 * (r >> 2);
#pragma unroll
        for (int d0 = 0; d0 < 4; ++d0) zr[r][d0] = *(const bf16_t*)((const char*)(Zw + (size_t)rc * NRC + d0 * 32) + zoff); }
#pragma unroll
    for (int r = 0; r < 16; ++r) { const int rc = (r & 3) + 8 * (r >> 2); const float rli = __builtin_amdgcn_rcpf(li_l[rc + 4 * hi]);
#pragma unroll
        for (int d0 = 0; d0 < 4; ++d0) { const float z = bf2f(zr[r][d0]); const float v = o[d0][r] * rli * siluf_(z);
            const float vn = __builtin_bit_cast(float, __builtin_amdgcn_mov_dpp(__builtin_bit_cast(int, v), 0xB1, 0xF, 0xF, true));
            if ((r32 & 1) == 0) *(unsigned*)((char*)(Ow + (size_t)rc * 1024 + d0 * 32) + ooff) = cvtpk(v, vn); } }
    QWRITE_R();
    __syncthreads();
#undef Kh
#undef Vh
#undef Rh
#undef RESC
#undef KBASE
#undef MASKT
#undef HALF_STEP
}
constexpr int NQUE = 8, BHQ = BPP * 8 / NQUE, QPER = BHQ * 32, OFF_QW = ATT_LDS;
__device__ __forceinline__ int unit_bh(int code) { const int q = code / QPER, v = code % QPER; return q * BHQ + v % BHQ; }
__device__ __forceinline__ BlockRef make_ref(int code) { BlockRef r; const int bh = unit_bh(code), a = code % QPER; r.bl = bh >> 3; r.h = bh & 7; r.qb = 31 - a / BHQ; return r; }
__device__ __forceinline__ int fetch_unit(unsigned* ctrs, LAS char* lds, int tid, unsigned x) {
    if (tid == 0) { volatile LAS unsigned* w = (volatile LAS unsigned*)(lds + OFF_QW); unsigned k = w[1]; int code = -1;
        while (k < (unsigned)NQUE) { const unsigned q = (x + k) & (NQUE - 1); const unsigned v = __hip_atomic_fetch_add(ctrs + q, 1u, __ATOMIC_RELAXED, __HIP_MEMORY_SCOPE_AGENT);
            if (v < (unsigned)QPER) { code = (int)(q * QPER + v); break; } ++k; }
        w[1] = k; w[0] = (unsigned)code; }
    __syncthreads();
    const int u = (int)*(volatile LAS unsigned*)(lds + OFF_QW);
    return __builtin_amdgcn_readfirstlane(u);
}
#undef KSWZ
#undef RSWZ
#undef SLOAD_H
#undef SWRITE_HK
#undef SWRITE_HV
#undef SWRITE_H
#undef QLOAD
#undef QLOAD_R
#undef QWRITE_R
#undef VMW
#undef VMWN
}


namespace hg {
constexpr int QI_S = 272, KT_S = 144, A_S = 144, ST_S = 272;
constexpr int OFF_QI = 0, OFF_KI = OFF_QI + 64 * QI_S, OFF_KOT = OFF_KI + 64 * QI_S, OFF_VT = OFF_KOT + 128 * KT_S, OFF_A = OFF_VT + 128 * KT_S,
              OFF_ST = OFF_A + 64 * A_S, OFF_SEG = OFF_ST + 128 * ST_S, OFF_DEC = OFF_SEG + 2048, OFF_SSQ = OFF_DEC + 512, HG_LDS = OFF_SSQ + 512;
#define MFMA16(a, b, c) __builtin_amdgcn_mfma_f32_16x16x32_bf16(a, b, c, 0, 0, 0)
__device__ __forceinline__ void hgrn_unit(const bf16_t* P, bf16_t* Y, const float* lb, const float* hgn, LAS unsigned char* lds, int bl, int h, int tid) {
    const int lane = tid & 63, w = __builtin_amdgcn_readfirstlane(tid >> 6), fr = lane & 15, fq = lane >> 4;
    const int k = tid & 127, seg = tid >> 7, tt = w & 3, vh = w >> 2;
    const float lbk = lb[h * 128 + k];
    for (int i = tid; i < 128 * ST_S / 16; i += 512) *(LAS u32x4*)(lds + OFF_ST + i * 16) = (u32x4){0u, 0u, 0u, 0u};
    f32x4 S[8];
#pragma unroll
    for (int i = 0; i < 8; ++i) S[i] = (f32x4){0.f, 0.f, 0.f, 0.f};
    const bf16_t* Pb = P + (size_t)bl * SEQ * NHC + h * 128;
    unsigned short rq[16], rf[16], ri[16];
    { const bf16_t* p = Pb + (size_t)(seg * 16) * NHC + k;
#pragma unroll
      for (int j = 0; j < 16; ++j) { rq[j] = p[(size_t)j * NHC + C_HQ]; rf[j] = p[(size_t)j * NHC + C_HF]; ri[j] = p[(size_t)j * NHC + C_HI]; } }
    LAS float* segs = (LAS float*)(lds + OFF_SEG); LAS float* decs = (LAS float*)(lds + OFF_DEC); LAS float* ssq = (LAS float*)(lds + OFF_SSQ);
    const float oml = 1.f - lbk; constexpr float L2E = 1.4426950408889634f;
    float c[16], om[16]; f32x4 o[4]; u32x2 rz[4];
#define HG_A1() do { float run = 0.f; _Pragma("unroll") for (int j = 0; j < 16; ++j) { const float sg = __builtin_amdgcn_rcpf(1.f + __builtin_amdgcn_exp2f(-L2E * bf2f(rf[j]))); \
            const float f = fmaf(oml, sg, lbk); om[j] = fmaf(-oml, sg, oml); run += __builtin_amdgcn_logf(f); c[j] = run; } segs[seg * 128 + k] = run; } while (0)
#define HG_OUT(t0_) do { const float tot = ssq[tt * 16 + fr] + ssq[64 + tt * 16 + fr]; const float rn = rsqrtf(tot * (1.f / 128.f) + EPS); \
          bf16_t* yp = Y + ((size_t)bl * SEQ + (t0_) + tt * 16 + fr) * 1024 + h * 128; \
          _Pragma("unroll") for (int i = 0; i < 4; ++i) { const int v0 = (vh * 4 + i) * 16 + 4 * fq; const f32x4 g4 = *(const f32x4*)(hgn + v0); \
              const float y0 = o[i][0] * rn * g4[0] * siluf_(bflo(rz[i].x)), y1 = o[i][1] * rn * g4[1] * siluf_(bfhi(rz[i].x)); \
              const float y2 = o[i][2] * rn * g4[2] * siluf_(bflo(rz[i].y)), y3 = o[i][3] * rn * g4[3] * siluf_(bfhi(rz[i].y)); \
              *(u32x2*)(yp + v0) = (u32x2){cvtpk_s(y0, y1), cvtpk_s(y2, y3)}; } } while (0)
    HG_A1();
#pragma unroll 1
    for (int n = 0; n < SEQ / 64; ++n) {
        const int t0 = n * 64;
        __syncthreads();
        if (n > 0) HG_OUT(t0 - 64);
#pragma unroll
        for (int i = 0; i < 4; ++i) rz[i] = *(const u32x2*)(Pb + (size_t)(t0 + tt * 16 + fr) * NHC + C_HZ + (vh * 4 + i) * 16 + 4 * fq);
        { const float s0 = segs[k], s1 = segs[128 + k], s2 = segs[256 + k], s3 = segs[384 + k];
          const float offs = (seg > 0 ? s0 : 0.f) + (seg > 1 ? s1 : 0.f) + (seg > 2 ? s2 : 0.f), total = (s0 + s1) + (s2 + s3);
          unsigned ko[8], vv[8];
          const float dk = __builtin_amdgcn_exp2f(total);
#pragma unroll
          for (int j = 0; j < 16; j += 2) {
              const float e0 = __builtin_amdgcn_exp2f(offs + c[j]), e1 = __builtin_amdgcn_exp2f(offs + c[j + 1]);
              const float r0 = __builtin_amdgcn_rcpf(e0), r1 = __builtin_amdgcn_rcpf(e1);
              const float hq0 = bf2f(rq[j]), hq1 = bf2f(rq[j + 1]);
              const float q0 = hq0 * e0 * __builtin_amdgcn_rcpf(1.f + __builtin_amdgcn_exp2f(-L2E * hq0)), q1 = hq1 * e1 * __builtin_amdgcn_rcpf(1.f + __builtin_amdgcn_exp2f(-L2E * hq1));
              const unsigned qw = cvtpk_s(q0, q1);
              const float ki0 = om[j] * r0, ki1 = om[j + 1] * r1;
              const unsigned kw = cvtpk_s(ki0, ki1);
              const int t = seg * 16 + j;
              *(LAS bf16_t*)(lds + OFF_QI + t * QI_S + k * 2) = (bf16_t)(qw & 0xffffu); *(LAS bf16_t*)(lds + OFF_QI + (t + 1) * QI_S + k * 2) = (bf16_t)(qw >> 16);
              *(LAS bf16_t*)(lds + OFF_KI + t * QI_S + k * 2) = (bf16_t)(kw & 0xffffu); *(LAS bf16_t*)(lds + OFF_KI + (t + 1) * QI_S + k * 2) = (bf16_t)(kw >> 16);
              ko[j >> 1] = cvtpk_s(ki0 * dk, ki1 * dk);
              vv[j >> 1] = (unsigned)ri[j] | ((unsigned)ri[j + 1] << 16);
          }
          *(LAS u32x4*)(lds + OFF_KOT + k * KT_S + seg * 32) = (u32x4){ko[0], ko[1], ko[2], ko[3]}; *(LAS u32x4*)(lds + OFF_KOT + k * KT_S + seg * 32 + 16) = (u32x4){ko[4], ko[5], ko[6], ko[7]};
          *(LAS u32x4*)(lds + OFF_VT + k * KT_S + seg * 32) = (u32x4){vv[0], vv[1], vv[2], vv[3]}; *(LAS u32x4*)(lds + OFF_VT + k * KT_S + seg * 32 + 16) = (u32x4){vv[4], vv[5], vv[6], vv[7]};
          if (seg == 0) decs[k] = dk;
        }
        { const int tn = (n + 1 < SEQ / 64 ? t0 + 64 : t0) + seg * 16; const bf16_t* p = Pb + (size_t)tn * NHC + k;
#pragma unroll
          for (int j = 0; j < 16; ++j) { rq[j] = p[(size_t)j * NHC + C_HQ]; rf[j] = p[(size_t)j * NHC + C_HF]; ri[j] = p[(size_t)j * NHC + C_HI]; } }
        __syncthreads();
        bf16x8 qf[4];
#pragma unroll
        for (int ks = 0; ks < 4; ++ks) qf[ks] = *(const LAS bf16x8*)(lds + OFF_QI + (tt * 16 + fr) * QI_S + (ks * 32 + 8 * fq) * 2);
#pragma unroll
        for (int si = 0; si < 2; ++si) { const int st = 2 * vh + si; f32x4 acc = (f32x4){0.f, 0.f, 0.f, 0.f};
            if (st <= tt) {
#pragma unroll
                for (int ks = 0; ks < 4; ++ks) { const bf16x8 kf = *(const LAS bf16x8*)(lds + OFF_KI + (st * 16 + fr) * QI_S + (ks * 32 + 8 * fq) * 2); acc = MFMA16(kf, qf[ks], acc); } }
            const int tg = tt * 16 + fr, sg = st * 16 + 4 * fq;
#pragma unroll
            for (int r = 0; r < 4; ++r) if (sg + r > tg) acc[r] = 0.f;
            *(LAS u32x2*)(lds + OFF_A + tg * A_S + sg * 2) = (u32x2){cvtpk_s(acc[0], acc[1]), cvtpk_s(acc[2], acc[3])}; }
#pragma unroll
        for (int i = 0; i < 4; ++i) { o[i] = (f32x4){0.f, 0.f, 0.f, 0.f}; const int vt = vh * 4 + i;
#pragma unroll
            for (int ks = 0; ks < 4; ++ks) { const bf16x8 sf = *(const LAS bf16x8*)(lds + OFF_ST + (vt * 16 + fr) * ST_S + (ks * 32 + 8 * fq) * 2); o[i] = MFMA16(sf, qf[ks], o[i]); } }
        __syncthreads();
        { bf16x8 af[2];
#pragma unroll
          for (int ks = 0; ks < 2; ++ks) af[ks] = *(const LAS bf16x8*)(lds + OFF_A + (tt * 16 + fr) * A_S + (ks * 32 + 8 * fq) * 2);
#pragma unroll
          for (int i = 0; i < 4; ++i) { const int vt = vh * 4 + i;
#pragma unroll
              for (int ks = 0; ks < 2; ++ks) { const bf16x8 vf = *(const LAS bf16x8*)(lds + OFF_VT + (vt * 16 + fr) * KT_S + (ks * 32 + 8 * fq) * 2); o[i] = MFMA16(vf, af[ks], o[i]); } } }
        { const f32x4 dec4 = *(const LAS f32x4*)(lds + OFF_DEC + (w * 16 + 4 * fq) * 4);
          bf16x8 kof[2];
#pragma unroll
          for (int ks = 0; ks < 2; ++ks) kof[ks] = *(const LAS bf16x8*)(lds + OFF_KOT + (w * 16 + fr) * KT_S + (ks * 32 + 8 * fq) * 2);
#pragma unroll
          for (int vt = 0; vt < 8; ++vt) { S[vt] = S[vt] * dec4;
#pragma unroll
              for (int ks = 0; ks < 2; ++ks) { const bf16x8 vf = *(const LAS bf16x8*)(lds + OFF_VT + (vt * 16 + fr) * KT_S + (ks * 32 + 8 * fq) * 2); S[vt] = MFMA16(kof[ks], vf, S[vt]); }
              *(LAS u32x2*)(lds + OFF_ST + (vt * 16 + fr) * ST_S + (w * 16 + 4 * fq) * 2) = (u32x2){cvtpk_s(S[vt][0], S[vt][1]), cvtpk_s(S[vt][2], S[vt][3])}; } }
        { float ss = 0.f;
#pragma unroll
          for (int i = 0; i < 4; ++i) ss += (o[i][0] * o[i][0] + o[i][1] * o[i][1]) + (o[i][2] * o[i][2] + o[i][3] * o[i][3]);
          ss += __shfl_xor(ss, 16); ss += __shfl_xor(ss, 32);
          if (fq == 0) ssq[vh * 64 + tt * 16 + fr] = ss; }
        HG_A1();
    }
    __syncthreads();
    HG_OUT(SEQ - 64);
    __syncthreads();
#undef HG_A1
#undef HG_OUT
}
#undef MFMA16
}

#define XB_TMO      128
#define XB_XCNT(j)  (256  + 64 * (j))
#define XB_XSUB(j)  (1280 + 64 * (j))
#define XB_XGEN(j)  (2304 + 64 * (j))
#define XB_TOP      3328
#define XB_TOPGEN   3392
#define XCD_BAR_WORDS 3456
#define XB_SPIN_CAP (1u << 20)
__device__ __forceinline__ unsigned xb_ld(unsigned* p)              { return __hip_atomic_load(p, __ATOMIC_RELAXED, __HIP_MEMORY_SCOPE_AGENT); }
__device__ __forceinline__ unsigned xb_add(unsigned* p, unsigned v) { return __hip_atomic_fetch_add(p, v, __ATOMIC_RELAXED, __HIP_MEMORY_SCOPE_AGENT); }
__device__ __forceinline__ unsigned xb_xcc_id() { return (unsigned)__builtin_amdgcn_s_getreg((3 << 11) | 20) & 0xFu; }
#define XB_SPIN(cond, bar) do { unsigned _sp = 0; while (cond) { __builtin_amdgcn_s_sleep(1); \
    if ((++_sp & 255u) == 0u) { if (xb_ld(&(bar)[XB_TMO])) break; if (_sp > XB_SPIN_CAP) { atomicAdd(&(bar)[XB_TMO], 1u); break; } } } } while (0)
struct XcdBarrier { unsigned* bar; unsigned x; volatile LAS unsigned* st; };
__device__ __forceinline__ XcdBarrier xcd_barrier_post(unsigned* bar, volatile LAS unsigned* st) {
    XcdBarrier b; b.bar = bar; b.x = xb_xcc_id(); b.st = st;
    if (threadIdx.x == 0) (void)xb_add(&bar[XB_XCNT(b.x)], 1u);
    return b;
}
__device__ __forceinline__ void xcd_barrier_complete(unsigned* bar, unsigned x, unsigned& nloc, unsigned& nx) {
    const unsigned G = gridDim.x * gridDim.y * gridDim.z;
    unsigned sum, cnt, mine, sp = 0u;
    for (;;) {
        sum = 0u; cnt = 0u; mine = 0u;
#pragma unroll
        for (unsigned j = 0; j < 16; ++j) { const unsigned c = xb_ld(&bar[XB_XCNT(j)]); sum += c; cnt += (c > 0u) ? 1u : 0u; mine = (j == x) ? c : mine; }
        if (sum == G) break;
        __builtin_amdgcn_s_sleep(1);
        if ((++sp & 255u) == 0u) { if (xb_ld(&bar[XB_TMO])) break; if (sp > XB_SPIN_CAP) { atomicAdd(&bar[XB_TMO], 1u); break; } }
    }
    nloc = mine > 0u ? mine : 1u; nx = cnt > 0u ? cnt : 1u;
}
__device__ __forceinline__ void xcd_barrier(unsigned* bar, volatile LAS unsigned* st) {
    asm volatile("s_waitcnt vmcnt(0)" ::: "memory");
    __syncthreads();
    if (threadIdx.x == 0) {
        const unsigned x = xb_xcc_id();
        __builtin_amdgcn_s_waitcnt(0);
        unsigned nloc = st[0], nx = st[1];
        if (nloc == 0u) { xcd_barrier_complete(bar, x, nloc, nx); st[0] = nloc; st[1] = nx; }
        const unsigned old = xb_add(&bar[XB_XSUB(x)], 1u);
        const unsigned gen = old / nloc;
        if (old + 1u == (gen + 1u) * nloc) {
            __builtin_amdgcn_fence(__ATOMIC_RELEASE, "agent");
            asm volatile("s_waitcnt vmcnt(0)" ::: "memory");
            const unsigned og = xb_add(&bar[XB_TOP], 1u);
            const unsigned tg = og / nx;
            if (og + 1u == (tg + 1u) * nx) xb_add(&bar[XB_TOPGEN], 1u);
            else XB_SPIN(xb_ld(&bar[XB_TOPGEN]) == tg, bar);
            __builtin_amdgcn_fence(__ATOMIC_ACQUIRE, "agent");
            xb_add(&bar[XB_XGEN(x)], 1u);
            asm volatile("s_waitcnt vmcnt(0)" ::: "memory");
        } else {
            XB_SPIN(xb_ld(&bar[XB_XGEN(x)]) == gen, bar);
            __builtin_amdgcn_fence(__ATOMIC_ACQUIRE, "agent");
            asm volatile("s_waitcnt vmcnt(0)" ::: "memory");
        }
    }
    __syncthreads();
}

__device__ __forceinline__ const void* karg_ptr(int byte_off) {
    const __attribute__((address_space(1))) void* p;
    const unsigned long long kpi = (unsigned long long)__builtin_amdgcn_kernarg_segment_ptr();
    const unsigned lo = __builtin_amdgcn_readfirstlane((unsigned)kpi), hi = __builtin_amdgcn_readfirstlane((unsigned)(kpi >> 32));
    const unsigned long long k2 = ((unsigned long long)hi << 32) | lo;
    asm volatile("s_load_dwordx2 %0, %1, %2\n\ts_waitcnt lgkmcnt(0)" : "=s"(p) : "s"(k2), "n"(byte_off) : "memory"); return (const void*)p;
}
static_assert(offsetof(Args, out) == 112 && offsetof(Args, ws) == 120, "kernarg offsets");
__global__ void __launch_bounds__(512, 2) mega_fwd(Args a) {
    extern __shared__ __attribute__((aligned(16))) unsigned char lds_raw[];
    LAS unsigned char* lds = (LAS unsigned char*)lds_raw;
    cg::grid_group grid = cg::this_grid();
    const int wave = wave_id_s();
#define TIDV (wave * 64 + lane_id_v())
#define BAR_ST ((volatile LAS unsigned*)(lds + LDS_BYTES - 64))
#define BAR_W ((unsigned*)((unsigned char*)karg_ptr(120) + WS_BAR))
#define GRID_BAR() xcd_barrier(BAR_W, BAR_ST)
    if (threadIdx.x == 0) { BAR_ST[0] = 0u; BAR_ST[1] = 0u; }
    if (blockIdx.x == 0) { unsigned* bw = BAR_W; for (int i = (int)threadIdx.x; i < XCD_BAR_WORDS; i += 512) bw[i] = 0u; }
    __syncthreads();
    const int G = gridDim.x, gw = blockIdx.x * 8 + wave, NGW = G * 8;
#define IN_(i) ((const float*)karg_ptr(8 * (i)))
#define x_in IN_(0)
#define norm_g IN_(1)
#define w_in IN_(2)
#define b_gate IN_(3)
#define lb_logits IN_(4)
#define hg_norm_g IN_(5)
#define q_a_g IN_(6)
#define w_uq IN_(7)
#define kv_a_g IN_(8)
#define w_ukv IN_(9)
#define w_pa IN_(10)
#define w_pb IN_(11)
#define w_out IN_(12)
#define final_g IN_(13)
#define OUT_ ((float*)karg_ptr(112))
#define WSL_ ((unsigned char*)karg_ptr(120))
#define WinT ((bf16_t*)(WSL_ + WS_WIN))
#define WuqT ((bf16_t*)(WSL_ + WS_WUQ))
#define WukvT ((bf16_t*)(WSL_ + WS_WUKV))
#define WpT ((bf16_t*)(WSL_ + WS_WP))
#define WoutT ((bf16_t*)(WSL_ + WS_WOUT))
#define cosT ((float*)(WSL_ + WS_COS))
#define sinT ((float*)(WSL_ + WS_SIN))
#define lbv ((float*)(WSL_ + WS_LB))
#define PH ((bf16_t*)(WSL_ + WS_PH))
#define PR ((bf16_t*)(WSL_ + WS_PR))
#define Qb ((bf16_t*)(WSL_ + WS_Q))
#define KVb ((bf16_t*)(WSL_ + WS_KV))
#define KPE ((bf16_t*)(WSL_ + WS_KPE))
#define Ya ((bf16_t*)OUT_)
#define Ybb ((bf16_t*)((unsigned char*)OUT_ + OUT_H_OFF))
#define T1 ((bf16_t*)(WSL_ + WS_T1))
#define MG ((bf16_t*)(WSL_ + WS_MG))
#define Hn ((bf16_t*)((unsigned char*)OUT_ + OUT_H_OFF))

#if !defined(SKIP0)
    for (int rep0_ = 0; rep0_ < REP0; ++rep0_)
    {
        const int lane = lane_id_v(); const int tidp = wave * 64 + lane;
        LAS float* scr = (LAS float*)(lds + wave * 16384);
        constexpr int I_IN = (DM / 64) * (NIN / 32), I_UQ = (QLORA / 64) * (NQ / 32), I_UKV = (KVLORA / 64) * (NKV / 32), I_SQ = (DM / 64) * (DM / 32);
        constexpr int NITEMS = I_IN + I_UQ + I_UKV + 3 * I_SQ;
        for (int it = gw; it < NITEMS; it += NGW) {
            int r = it;
            if (r < I_IN) { transpose_item(w_in, DM, NIN, WinT, 0, nullptr, scr, r, lane); continue; } r -= I_IN;
            if (r < I_UQ) { transpose_item<true>(w_uq, QLORA, NQ, WuqT, 0, q_a_g, scr, r, lane); continue; } r -= I_UQ;
            if (r < I_UKV) { transpose_item(w_ukv, KVLORA, NKV, WukvT, 0, kv_a_g, scr, r, lane); continue; } r -= I_UKV;
            if (r < I_SQ) { transpose_item(w_pa, DM, DM, WpT, 0, nullptr, scr, r, lane); continue; } r -= I_SQ;
            if (r < I_SQ) { transpose_item(w_pb, DM, DM, WpT, 1024, nullptr, scr, r, lane); continue; } r -= I_SQ;
            transpose_item(w_out, DM, DM, WoutT, 0, nullptr, scr, r, lane);
        }
        for (int i = blockIdx.x * 512 + tidp; i < (NINP - NIN) * DM / 8; i += G * 512) *(u32x4*)(WinT + (size_t)NIN * DM + (size_t)i * 8) = (u32x4){0u, 0u, 0u, 0u};
        for (int i = blockIdx.x * 512 + tidp; i < SEQ * 32; i += G * 512) { const int pos = i >> 5, f = i & 31; const float ang = (float)pos * a.inv[f];
            const double r = (double)ang * 0.15915494309189535; const double fr = r - __builtin_rint(r);
            const float rad = (float)(fr * 6.283185307179586);
            cosT[i] = __cosf(rad); sinT[i] = __sinf(rad); }
        if (blockIdx.x == 0 && tidp < 64) ((unsigned*)(WSL_ + WS_CTR))[tidp] = 0u;
        for (int i = blockIdx.x * 512 + tidp; i < 1024; i += G * 512) lbv[i] = sigmoidf_(lb_logits[i] - lb_logits[1024 + i]);
        { const float* xp = x_in; bf16_t* hp = Hn; const f32x4* gp = (const f32x4*)norm_g; f32x4 gg[4];
#pragma unroll
          for (int j = 0; j < 4; ++j) gg[j] = gp[lane + 64 * j];
          for (int m0 = gw * 4; m0 < TTOK; m0 += NGW * 4) {
            f32x4 v[4][4];
#pragma unroll
            for (int r = 0; r < 4; ++r)
#pragma unroll
                for (int j = 0; j < 4; ++j) v[r][j] = ((const f32x4*)(xp + (size_t)(m0 + r) * DM))[lane + 64 * j];
#pragma unroll
            for (int r = 0; r < 4; ++r) { float sq = 0.f;
#pragma unroll
                for (int j = 0; j < 4; ++j) sq += (v[r][j].x * v[r][j].x + v[r][j].y * v[r][j].y) + (v[r][j].z * v[r][j].z + v[r][j].w * v[r][j].w);
                const float rn = rsqrtf(wave_sum(sq) * (1.f / DM) + EPS);
                unsigned long long* o8 = (unsigned long long*)(hp + (size_t)(m0 + r) * DM) + lane;
#pragma unroll
                for (int j = 0; j < 4; ++j) o8[64 * j] = (unsigned long long)pk2(v[r][j].x * rn * gg[j].x, v[r][j].y * rn * gg[j].y) | ((unsigned long long)pk2(v[r][j].z * rn * gg[j].z, v[r][j].w * rn * gg[j].w) << 32); }
          } }
    }
#endif
    grid.sync();
    if (threadIdx.x == 0) (void)xb_add(&BAR_W[XB_XCNT(xb_xcc_id())], 1u);

    { pg8::Gemm g{Hn, WinT, DM, DM, DM}; pg8::SchedPlain S; S.per = 0; S.rep = 1; S.o.init(TH, NHC, G, (int)blockIdx.x);
      pg8::EpiBf16 E{PH, NHC}; pg8::gemm_phase(lds, g, S, E, wave); }
    GRID_BAR();
    if ((int)blockIdx.x < BPP * 8) { const int tidp = TIDV; const int u = (int)blockIdx.x; hg::hgrn_unit(PH, Ya, lbv, hg_norm_g, lds, u >> 3, u & 7, tidp); }
    else { pg8::Gemm g{Hn, WinT + (size_t)NHC * DM, DM, DM, DM}; pg8::SchedPlain S; S.per = 0; S.rep = 1; S.o.init(TH, NRC, G - BPP * 8, (int)blockIdx.x - BPP * 8);
      pg8::EpiBf16 E{PR, NRC}; pg8::gemm_phase(lds, g, S, E, wave); }
    GRID_BAR();
    { const int lane = lane_id_v();
      bf16_t* Pp = PR; bf16_t* Kp = KPE; const float* ct = cosT; const float* st = sinT;
      for (int m0 = gw * 4; m0 < TH; m0 += NGW * 4) {
        u32x4 vq[4], vk[4]; unsigned short k1[4], k2[4]; float cc[4], sn[4];
#pragma unroll
        for (int r = 0; r < 4; ++r) { const bf16_t* pr = Pp + (size_t)(m0 + r) * NRC; const int pos = (m0 + r) & (SEQ - 1);
            vq[r] = (u32x4){0u, 0u, 0u, 0u}; vk[r] = (u32x4){0u, 0u, 0u, 0u}; k1[r] = 0; k2[r] = 0; cc[r] = 0.f; sn[r] = 0.f;
            if (lane < 48) vq[r] = *(const u32x4*)(pr + R_CQ + lane * 8);
            if (lane < 32) { vk[r] = *(const u32x4*)(pr + R_CKV + lane * 8); k1[r] = pr[R_KR + lane]; k2[r] = pr[R_KR + 32 + lane]; cc[r] = ct[pos * 32 + lane]; sn[r] = st[pos * 32 + lane]; } }
#pragma unroll
        for (int r = 0; r < 4; ++r) { bf16_t* pr = Pp + (size_t)(m0 + r) * NRC;
          { const u32x4 v = vq[r]; float f[8] = {bflo(v.x), bfhi(v.x), bflo(v.y), bfhi(v.y), bflo(v.z), bfhi(v.z), bflo(v.w), bfhi(v.w)}; float sq = 0.f;
#pragma unroll
            for (int e = 0; e < 8; ++e) sq += f[e] * f[e];
            const float rn = rsqrtf(wave_sum(sq) * (1.f / QLORA) + EPS);
            if (lane < 48) { u32x4 o; o.x = pk2(f[0] * rn, f[1] * rn); o.y = pk2(f[2] * rn, f[3] * rn); o.z = pk2(f[4] * rn, f[5] * rn); o.w = pk2(f[6] * rn, f[7] * rn); *(u32x4*)(pr + R_CQ + lane * 8) = o; } }
          { const u32x4 v = vk[r]; float f[8] = {bflo(v.x), bfhi(v.x), bflo(v.y), bfhi(v.y), bflo(v.z), bfhi(v.z), bflo(v.w), bfhi(v.w)}; float sq = 0.f;
#pragma unroll
            for (int e = 0; e < 8; ++e) sq += f[e] * f[e];
            const float rn = rsqrtf(wave_sum(sq) * (1.f / KVLORA) + EPS);
            if (lane < 32) { u32x4 o; o.x = pk2(f[0] * rn, f[1] * rn); o.y = pk2(f[2] * rn, f[3] * rn); o.z = pk2(f[4] * rn, f[5] * rn); o.w = pk2(f[6] * rn, f[7] * rn); *(u32x4*)(pr + R_CKV + lane * 8) = o; } }
          if (lane < 32) { const float x1 = bf2f(k1[r]), x2 = bf2f(k2[r]);
            Kp[(size_t)(m0 + r) * 64 + lane] = (bf16_t)f2bf(x1 * cc[r] - x2 * sn[r]); Kp[(size_t)(m0 + r) * 64 + 32 + lane] = (bf16_t)f2bf(x2 * cc[r] + x1 * sn[r]); } }
      } }
    GRID_BAR();
    { pg8::Gemm g{PR + R_CQ, WuqT, NRC, QLORA, QLORA}; pg8::SchedPlain S; S.per = 0; S.rep = 1; S.o.init(TH, NQ, G, (int)blockIdx.x);
      pg8::EpiQRope E{Qb, cosT, sinT}; pg8::gemm_phase(lds, g, S, E, wave); }
    { pg8::Gemm g{PR + R_CKV, WukvT, NRC, KVLORA, KVLORA}; pg8::SchedPlain S; S.per = 0; S.rep = 1; S.o.init(TH, NKV, G, (int)blockIdx.x);
      pg8::EpiBf16 E{KVb, NKV}; pg8::gemm_phase(lds, g, S, E, wave); }
    GRID_BAR();
    { const int tidp = TIDV;
      unsigned* ctrs = (unsigned*)(WSL_ + WS_CTR); const unsigned xcd = xb_xcc_id() & (att::NQUE - 1);
      const att::Bases B{Qb, KVb, KPE, PR, Ybb};
      if (tidp == 0) ((volatile LAS unsigned*)(lds + att::OFF_QW))[1] = 0u;
      int u = att::fetch_unit(ctrs, (LAS char*)lds, tidp, xcd);
      if (u >= 0) {
          att::BlockRef cur = att::make_ref(u); att::Seam S;
          att::attn_prime(B, cur, (LAS char*)lds, S, tidp);
          for (;;) { const int un = att::fetch_unit(ctrs, (LAS char*)lds, tidp, xcd); const bool last = un < 0;
              const att::BlockRef nxt = last ? cur : att::make_ref(un);
              att::attn_block(B, cur, nxt, (LAS char*)lds, S, tidp);
              if (last) break; cur = nxt; }
      } }
    GRID_BAR();
    { pg8::Gemm g{Ya, WpT, DM, DM, DM}; pg8::SchedAB S; S.per = 0; S.rep = 1; S.o.init(TH, DM, G, (int)blockIdx.x);
      pg8::EpiGate E{PR, b_gate, T1, MG}; pg8::gemm_phase(lds, g, S, E, wave); }
    GRID_BAR();
    for (int pm = (int)blockIdx.x; pm < TH / 256; pm += G) {
      { pg8::Gemm g{MG, WoutT, DM, DM, DM}; pg8::SchedRow S{pm};
        pg8::EpiResid E{x_in, OUT_}; pg8::gemm_phase(lds, g, S, E, wave); }
      asm volatile("s_waitcnt vmcnt(0)" ::: "memory"); __syncthreads();
      { const int lane = lane_id_v();
        float* op = OUT_ + (size_t)pm * 256 * DM; const f32x4* gp = (const f32x4*)final_g; f32x4 gg[4];
#pragma unroll
        for (int j = 0; j < 4; ++j) gg[j] = gp[lane + 64 * j];
        for (int m0 = wave * 4; m0 < 256; m0 += 32) {
          f32x4 v[4][4];
#pragma unroll
          for (int r = 0; r < 4; ++r)
#pragma unroll
              for (int j = 0; j < 4; ++j) v[r][j] = ((const f32x4*)(op + (size_t)(m0 + r) * DM))[lane + 64 * j];
#pragma unroll
          for (int r = 0; r < 4; ++r) { float sq = 0.f;
#pragma unroll
              for (int j = 0; j < 4; ++j) sq += (v[r][j].x * v[r][j].x + v[r][j].y * v[r][j].y) + (v[r][j].z * v[r][j].z + v[r][j].w * v[r][j].w);
              const float rn = rsqrtf(wave_sum(sq) * (1.f / DM) + EPS);
#pragma unroll
              for (int j = 0; j < 4; ++j) ((f32x4*)(op + (size_t)(m0 + r) * DM))[lane + 64 * j] = v[r][j] * rn * gg[j]; }
        } }
      __syncthreads();
    }
}

extern "C" void kernel_launch(void* const* d_in, const int* in_sizes, int n_in, void* d_out, int out_size, void* d_ws, size_t ws_size, hipStream_t stream) {
    static int grid = 0;
    if (grid == 0) {
        if (n_in != 14 || in_sizes[0] != TTOK * DM || out_size != TTOK * DM || ws_size < WS_END) { fprintf(stderr, "kernel_launch: shape/workspace mismatch (n_in %d, ws %zu, need %zu)\n", n_in, ws_size, (size_t)WS_END); grid = -1; return; }
        int dev = 0, cus = 0, per_cu = 0;
        if (hipGetDevice(&dev) != hipSuccess || hipDeviceGetAttribute(&cus, hipDeviceAttributeMultiprocessorCount, dev) != hipSuccess) { grid = -1; return; }
        if (hipFuncSetAttribute((const void*)mega_fwd, hipFuncAttributeMaxDynamicSharedMemorySize, LDS_BYTES) != hipSuccess) { fprintf(stderr, "kernel_launch: hipFuncSetAttribute failed\n"); grid = -1; return; }
        if (hipOccupancyMaxActiveBlocksPerMultiprocessor(&per_cu, (const void*)mega_fwd, 512, LDS_BYTES) != hipSuccess || per_cu < 1) { fprintf(stderr, "kernel_launch: occupancy query says %d\n", per_cu); per_cu = 1; }
        (void)hipGetLastError();
        grid = cus;
    }
    if (grid < 0) return;
    Args a{};
    for (int i = 0; i < 14; ++i) a.in[i] = (const float*)d_in[i];
    a.out = (float*)d_out; a.ws = (unsigned char*)d_ws;
    for (int i = 0; i < 32; ++i) a.inv[i] = powf(10000.0f, -(float)(2 * i) / 64.0f);
    void* args[] = {&a};
    hipError_t e = hipLaunchCooperativeKernel((const void*)mega_fwd, dim3(grid), dim3(512), args, LDS_BYTES, stream);
    if (e != hipSuccess) fprintf(stderr, "cooperative launch failed: %s (grid %d)\n", hipGetErrorString(e), grid);
}
```
